# Optimizing an MI355X kernel written in HIP

```python
import math
import jax, jax.numpy as jnp
from jax import lax
import numpy as np

D_MODEL = 2048
BATCH = 8
SEQ = 2048
DEPTH = 4

N_MIXERS = 2
N_NSA_LAYERS = (DEPTH + N_MIXERS - 1) // N_MIXERS
N_MLSTM_LAYERS = DEPTH // N_MIXERS

D_FF = 5632
FFN_RES = 0.5
N_MOD = 9
RMS_EPS = 1e-6
NEG_INF = -1e30

NSA_HEADS = 16
NSA_HEAD_DIM = 128
NSA_KV_GROUPS = 4
NSA_HPG = NSA_HEADS // NSA_KV_GROUPS
NSA_Q_DIM = NSA_HEADS * NSA_HEAD_DIM
NSA_KV_DIM = NSA_KV_GROUPS * NSA_HEAD_DIM
NSA_IN_DIM = NSA_Q_DIM + 6 * NSA_KV_DIM + 3 * NSA_HEADS
CMP_BLOCK = 32
CMP_STRIDE = 16
CMP_HIDDEN = 512
SEL_BLOCK = 64
SEL_TOPK = 16
N_LOCAL_BLOCKS = 2
FORCE_SCORE = 1e9
WINDOW = 512
Q_BLOCK = 128
SEL_Q_BLOCK = 32
ROPE_THETA = 10000.0

ML_HEADS = 8
ML_QK_DIM = 128
ML_V_DIM = 256
ML_CONV = 4
ML_CHUNK = 64
ML_QK_COLS = 2 * ML_HEADS * ML_QK_DIM
ML_IN_DIM = ML_QK_COLS + 2 * ML_HEADS * ML_V_DIM + 2 * ML_HEADS

kernel_name = 'hybrid_nsa_mlstm_macaron_adaln'


def rms_norm(x, g):
    xf = x.astype(jnp.float32)
    y = xf * lax.rsqrt(jnp.mean(xf * xf, axis=-1, keepdims=True) + RMS_EPS)
    return (y * g.astype(jnp.float32)).astype(x.dtype)


def rope(x, pos):
    half = x.shape[-1] // 2
    freqs = ROPE_THETA ** (-jnp.arange(half, dtype=jnp.float32) / half)
    ang = pos.astype(jnp.float32)[:, None] * freqs[None, :]
    cos, sin = jnp.cos(ang), jnp.sin(ang)
    xf = x.astype(jnp.float32)
    x1, x2 = xf[..., :half], xf[..., half:]
    return jnp.concatenate([x1 * cos - x2 * sin, x2 * cos + x1 * sin], axis=-1).astype(x.dtype)


def masked_softmax(s, mask):
    s = jnp.where(mask, s.astype(jnp.float32), NEG_INF)
    p = jax.nn.softmax(s, axis=-1)
    return jnp.where(mask, p, 0.0)


def swiglu(h, w_in, w_out):
    g, u = jnp.split(h @ w_in, 2, axis=-1)
    return (jax.nn.silu(g) * u) @ w_out


def nsa_mixer(h, w_in, cmp_pos, cmp_w1, cmp_w2, w_out):
    B, S, _ = h.shape
    G, R, Dh = NSA_KV_GROUPS, NSA_HPG, NSA_HEAD_DIM
    scale = Dh ** -0.5
    sizes = [NSA_Q_DIM] + [NSA_KV_DIM] * 6 + [3 * NSA_HEADS]
    cuts = np.cumsum(sizes)[:-1].tolist()
    q, k_c, v_c, k_s, v_s, k_w, v_w, gate_logits = jnp.split(h @ w_in, cuts, axis=-1)
    q = q.reshape(B, S, G, R, Dh).transpose(0, 2, 3, 1, 4)

    def kv(t):
        return t.reshape(B, S, G, Dh).transpose(0, 2, 1, 3)

    k_c, v_c, k_s, v_s, k_w, v_w = kv(k_c), kv(v_c), kv(k_s), kv(v_s), kv(k_w), kv(v_w)
    pos = jnp.arange(S)
    q_rot = rope(q, pos)
    k_s = rope(k_s, pos)
    k_w = rope(k_w, pos)

    n_cmp = (S - CMP_BLOCK) // CMP_STRIDE + 1
    cmp_start = jnp.arange(n_cmp) * CMP_STRIDE
    blk_idx = cmp_start[:, None] + jnp.arange(CMP_BLOCK)[None, :]

    def compress(t, pe, w1, w2):
        blocks = t[:, :, blk_idx, :] + pe
        flat = blocks.reshape(B, G, n_cmp, CMP_BLOCK * Dh)
        return jax.nn.silu(flat @ w1) @ w2

    kc = compress(k_c, cmp_pos[0], cmp_w1[0], cmp_w2[0])
    vc = compress(v_c, cmp_pos[1], cmp_w1[1], cmp_w2[1])
    cmp_end = cmp_start + CMP_BLOCK - 1
    s_c = jnp.einsum('bgrqd,bgcd->bgrqc', q, kc) * scale
    p_c = masked_softmax(s_c, cmp_end[None, :] <= pos[:, None])
    o_cmp = jnp.einsum('bgrqc,bgcd->bgrqd', p_c.astype(vc.dtype), vc)

    n_sel = S // SEL_BLOCK
    jsel = jnp.arange(n_sel)
    cover = ((cmp_start[:, None] < (jsel[None, :] + 1) * SEL_BLOCK) &
             (cmp_start[:, None] + CMP_BLOCK > jsel[None, :] * SEL_BLOCK)).astype(jnp.float32)
    imp = jnp.einsum('bgrqc,cj->bgqj', p_c, cover)
    q_blk = pos // SEL_BLOCK
    causal_blk = jsel[None, :] <= q_blk[:, None]
    forced = (jsel[None, :] == 0) | (causal_blk & (jsel[None, :] > q_blk[:, None] - N_LOCAL_BLOCKS))
    imp = jnp.where(forced, FORCE_SCORE, jnp.where(causal_blk, imp, -1.0))
    top_k = min(SEL_TOPK, n_sel)
    top_val, top_idx = lax.top_k(imp, top_k)
    top_ok = top_val >= 0.0

    ks_blocks = k_s.reshape(B, G, n_sel, SEL_BLOCK, Dh)
    vs_blocks = v_s.reshape(B, G, n_sel, SEL_BLOCK, Dh)
    nq = S // SEL_Q_BLOCK
    q_chunks = jnp.moveaxis(q_rot.reshape(B, G, R, nq, SEL_Q_BLOCK, Dh), 3, 0)
    idx_chunks = jnp.moveaxis(top_idx.reshape(B, G, nq, SEL_Q_BLOCK, top_k), 2, 0)
    ok_chunks = jnp.moveaxis(top_ok.reshape(B, G, nq, SEL_Q_BLOCK, top_k), 2, 0)
    pos_chunks = pos.reshape(nq, SEL_Q_BLOCK)
    b_ix = jnp.arange(B)[:, None, None, None]
    g_ix = jnp.arange(G)[None, :, None, None]
    tok_in_blk = jnp.arange(SEL_BLOCK)
    n_keys = top_k * SEL_BLOCK

    def sel_chunk(args):
        qc, idx, ok, tq = args
        kg = ks_blocks[b_ix, g_ix, idx]
        vg = vs_blocks[b_ix, g_ix, idx]
        s = jnp.einsum('bgrqd,bgqkld->bgrqkl', qc, kg) * scale
        key_pos = idx[..., None] * SEL_BLOCK + tok_in_blk
        mask = ok[..., None] & (key_pos <= tq[None, None, :, None, None])
        p = masked_softmax(s.reshape(B, G, R, SEL_Q_BLOCK, n_keys),
                           mask.reshape(B, G, 1, SEL_Q_BLOCK, n_keys))
        p = p.reshape(B, G, R, SEL_Q_BLOCK, top_k, SEL_BLOCK).astype(vg.dtype)
        return jnp.einsum('bgrqkl,bgqkld->bgrqd', p, vg)

    o_sel = lax.map(sel_chunk, (q_chunks, idx_chunks, ok_chunks, pos_chunks))
    o_sel = jnp.moveaxis(o_sel, 0, 3).reshape(B, G, R, S, Dh)

    nb = S // Q_BLOCK
    span = WINDOW + Q_BLOCK
    kw_pad = jnp.pad(k_w, ((0, 0), (0, 0), (WINDOW, 0), (0, 0)))
    vw_pad = jnp.pad(v_w, ((0, 0), (0, 0), (WINDOW, 0), (0, 0)))
    qw_chunks = jnp.moveaxis(q_rot.reshape(B, G, R, nb, Q_BLOCK, Dh), 3, 0)
    offs = jnp.arange(span)
    q_offs = jnp.arange(Q_BLOCK)

    def win_chunk(args):
        qc, blk = args
        start = blk * Q_BLOCK
        kb = lax.dynamic_slice_in_dim(kw_pad, start, span, axis=2)
        vb = lax.dynamic_slice_in_dim(vw_pad, start, span, axis=2)
        s = jnp.einsum('bgrqd,bgkd->bgrqk', qc, kb) * scale
        tq = start + q_offs
        kp = start - WINDOW + offs
        mask = (kp[None, :] >= 0) & (kp[None, :] <= tq[:, None]) & (tq[:, None] - kp[None, :] < WINDOW)
        p = masked_softmax(s, mask).astype(vb.dtype)
        return jnp.einsum('bgrqk,bgkd->bgrqd', p, vb)

    o_win = lax.map(win_chunk, (qw_chunks, jnp.arange(nb)))
    o_win = jnp.moveaxis(o_win, 0, 3).reshape(B, G, R, S, Dh)

    gates = jax.nn.sigmoid(gate_logits.reshape(B, S, G, R, 3).transpose(0, 2, 3, 1, 4))
    o = gates[..., 0:1] * o_cmp + gates[..., 1:2] * o_sel + gates[..., 2:3] * o_win
    o = o.transpose(0, 3, 1, 2, 4).reshape(B, S, NSA_Q_DIM)
    return o @ w_out


def mlstm_cell(q, k, v, ig, logf):
    B, H, S, dk = q.shape
    dv = v.shape[-1]
    L = ML_CHUNK
    nc = S // L
    q = q.reshape(B, H, nc, L, dk)
    k = k.reshape(B, H, nc, L, dk)
    v = v.reshape(B, H, nc, L, dv)
    ig = ig.reshape(B, H, nc, L)
    b = jnp.cumsum(logf.reshape(B, H, nc, L), axis=-1)
    b_tot = b[..., -1]

    w_end = b_tot[..., None] - b + ig
    m_loc = jnp.max(w_end, axis=-1)
    e_end = jnp.exp(w_end - m_loc[..., None])
    C_loc = jnp.einsum('bhcs,bhcsv,bhcsk->bhcvk', e_end, v, k)
    n_loc = jnp.einsum('bhcs,bhcsk->bhck', e_end, k)

    def step(carry, xs):
        C, n, m = carry
        C_l, n_l, m_l, bt = xs
        m_new = jnp.maximum(bt + m, m_l)
        a = jnp.exp(bt + m - m_new)
        bc = jnp.exp(m_l - m_new)
        C_new = a[..., None, None] * C + bc[..., None, None] * C_l
        n_new = a[..., None] * n + bc[..., None] * n_l
        return (C_new, n_new, m_new), (C, n, m)

    init = (jnp.zeros((B, H, dv, dk), jnp.float32), jnp.zeros((B, H, dk), jnp.float32),
            jnp.zeros((B, H), jnp.float32))
    xs = (jnp.moveaxis(C_loc, 2, 0), jnp.moveaxis(n_loc, 2, 0),
          jnp.moveaxis(m_loc, 2, 0), jnp.moveaxis(b_tot, 2, 0))
    _, (C_prev, n_prev, m_prev) = lax.scan(step, init, xs)
    C_prev = jnp.moveaxis(C_prev, 0, 2)
    n_prev = jnp.moveaxis(n_prev, 0, 2)
    m_prev = jnp.moveaxis(m_prev, 0, 2)

    log_inter = b + m_prev[..., None]
    causal = jnp.tril(jnp.ones((L, L), dtype=bool))
    log_intra = jnp.where(causal, b[..., :, None] - b[..., None, :] + ig[..., None, :], -jnp.inf)
    m_t = jnp.maximum(log_inter, jnp.max(log_intra, axis=-1))
    e_inter = jnp.exp(log_inter - m_t)
    e_intra = jnp.exp(log_intra - m_t[..., None])
    qk = jnp.einsum('bhctd,bhcsd->bhcts', q, k) * e_intra
    num = (jnp.einsum('bhcts,bhcsv->bhctv', qk, v) +
           e_inter[..., None] * jnp.einsum('bhcvk,bhctk->bhctv', C_prev, q))
    den = qk.sum(-1) + e_inter * jnp.einsum('bhck,bhctk->bhct', n_prev, q)
    h = num / jnp.maximum(jnp.abs(den), jnp.exp(-m_t))[..., None]
    return h.reshape(B, H, S, dv)


def mlstm_mixer(h, w_in, conv_w, conv_b, gate_b, mh_gain, w_out):
    B, S, _ = h.shape
    H, dk, dv = ML_HEADS, ML_QK_DIM, ML_V_DIM
    cuts = [ML_QK_COLS, ML_QK_COLS + H * dv, ML_QK_COLS + 2 * H * dv, ML_QK_COLS + 2 * H * dv + H]
    qk, v, o, ig, fg = jnp.split(h @ w_in, cuts, axis=-1)
    qk = lax.conv_general_dilated(qk, conv_w[:, None, :], window_strides=(1,),
                                  padding=[(ML_CONV - 1, 0)],
                                  dimension_numbers=('NWC', 'WIO', 'NWC'),
                                  feature_group_count=ML_QK_COLS)
    qk = jax.nn.silu(qk + conv_b)
    q, k = jnp.split(qk, 2, axis=-1)

    def heads(t, d):
        return t.reshape(B, S, H, d).transpose(0, 2, 1, 3).astype(jnp.float32)

    q = heads(q, dk)
    k = heads(k, dk) * (dk ** -0.5)
    v = heads(v, dv)
    ig = (ig + gate_b[0]).astype(jnp.float32).transpose(0, 2, 1)
    logf = jax.nn.log_sigmoid((fg + gate_b[1]).astype(jnp.float32)).transpose(0, 2, 1)
    hc = mlstm_cell(q, k, v, ig, logf)
    hn = hc * lax.rsqrt(jnp.mean(hc * hc, axis=-1, keepdims=True) + RMS_EPS)
    hn = hn.transpose(0, 2, 1, 3).reshape(B, S, H * dv) * mh_gain.astype(jnp.float32)
    out = jax.nn.sigmoid(o) * hn.astype(h.dtype)
    return out @ w_out


def setup_inputs(seed: int = 0) -> dict:
    key = jax.random.key(seed)
    ks = jax.random.split(key, 24)

    def w(k, shape, fan_in, mult=1.0):
        return jax.random.normal(k, shape, jnp.float32) * (mult * fan_in ** -0.5)

    def nrm(k, shape, s):
        return jax.random.normal(k, shape, jnp.float32) * s

    D, NL, ML = D_MODEL, N_NSA_LAYERS, N_MLSTM_LAYERS
    forget_b = jnp.linspace(3.0, 6.0, ML_HEADS, dtype=jnp.float32)[None, :] + nrm(ks[21], (ML, ML_HEADS), 0.1)
    input_b = nrm(ks[22], (ML, ML_HEADS), 0.1)
    return {
        'x': nrm(ks[0], (BATCH, SEQ, D), 1.0),
        'c': nrm(ks[1], (BATCH, D), 1.0),
        'mod_w': w(ks[2], (DEPTH, D, N_MOD * D), D, 0.5),
        'mod_b': nrm(ks[3], (DEPTH, N_MOD * D), 0.02),
        'norm_g': 1.0 + nrm(ks[4], (DEPTH, 6, D), 0.05),
        'ffn_pre_w_in': w(ks[5], (DEPTH, D, 2 * D_FF), D),
        'ffn_pre_w_out': w(ks[6], (DEPTH, D_FF, D), D_FF),
        'ffn_post_w_in': w(ks[7], (DEPTH, D, 2 * D_FF), D),
        'ffn_post_w_out': w(ks[8], (DEPTH, D_FF, D), D_FF),
        'nsa_w_in': w(ks[9], (NL, D, NSA_IN_DIM), D),
        'nsa_cmp_pos': nrm(ks[10], (NL, 2, CMP_BLOCK, NSA_HEAD_DIM), 0.5),
        'nsa_cmp_w1': w(ks[11], (NL, 2, CMP_BLOCK * NSA_HEAD_DIM, CMP_HIDDEN), CMP_BLOCK * NSA_HEAD_DIM),
        'nsa_cmp_w2': w(ks[12], (NL, 2, CMP_HIDDEN, NSA_HEAD_DIM), CMP_HIDDEN),
        'nsa_w_out': w(ks[13], (NL, NSA_Q_DIM, D), NSA_Q_DIM),
        'ml_w_in': w(ks[14], (ML, D, ML_IN_DIM), D),
        'ml_conv_w': w(ks[15], (ML, ML_CONV, ML_QK_COLS), ML_CONV),
        'ml_conv_b': nrm(ks[16], (ML, ML_QK_COLS), 0.02),
        'ml_gate_b': jnp.stack([input_b, forget_b], axis=1),
        'ml_mh_gain': 1.0 + nrm(ks[17], (ML, ML_HEADS * ML_V_DIM), 0.05),
        'ml_w_out': w(ks[18], (ML, ML_HEADS * ML_V_DIM, D), ML_HEADS * ML_V_DIM),
    }


def reference(x, c, mod_w, mod_b, norm_g, ffn_pre_w_in, ffn_pre_w_out, ffn_post_w_in, ffn_post_w_out,
              nsa_w_in, nsa_cmp_pos, nsa_cmp_w1, nsa_cmp_w2, nsa_w_out,
              ml_w_in, ml_conv_w, ml_conv_b, ml_gate_b, ml_mh_gain, ml_w_out):
    c_act = jax.nn.silu(c)

    def pre(h, g, shift, scale):
        return rms_norm(h, g) * (1.0 + scale[:, None, :]) + shift[:, None, :]

    for i in range(DEPTH):
        mod = c_act @ mod_w[i] + mod_b[i]
        sh1, sc1, g1, sh2, sc2, g2, sh3, sc3, g3 = jnp.split(mod, N_MOD, axis=-1)
        y = swiglu(pre(x, norm_g[i, 0], sh1, sc1), ffn_pre_w_in[i], ffn_pre_w_out[i])
        x = x + FFN_RES * g1[:, None, :] * rms_norm(y, norm_g[i, 1])
        h = pre(x, norm_g[i, 2], sh2, sc2)
        j = i // N_MIXERS
        if i % N_MIXERS == 0:
            y = nsa_mixer(h, nsa_w_in[j], nsa_cmp_pos[j], nsa_cmp_w1[j], nsa_cmp_w2[j], nsa_w_out[j])
        else:
            y = mlstm_mixer(h, ml_w_in[j], ml_conv_w[j], ml_conv_b[j], ml_gate_b[j], ml_mh_gain[j], ml_w_out[j])
        x = x + g2[:, None, :] * rms_norm(y, norm_g[i, 3])
        y = swiglu(pre(x, norm_g[i, 4], sh3, sc3), ffn_post_w_in[i], ffn_post_w_out[i])
        x = x + FFN_RES * g3[:, None, :] * rms_norm(y, norm_g[i, 5])
    return x
```

```cpp
#include <hip/hip_runtime.h>
#include <cstdio>
#include <cstdint>

namespace pg8 {
#define PG8_LAS __attribute__((address_space(3)))
typedef unsigned short bf16_t;
typedef short bf16x8 __attribute__((ext_vector_type(8)));
typedef float f32x4 __attribute__((ext_vector_type(4)));
typedef unsigned u32x4 __attribute__((ext_vector_type(4)));
typedef unsigned u32x2 __attribute__((ext_vector_type(2)));
constexpr int BM = 256, BK = 64, HALF = 128, HTB = HALF * BK * 2  , STAGE_BYTES = 8 * HTB, NXCD = 8, WGM = 8;

__host__ __device__ __forceinline__ int lds_byte(int r, int c) { const int st = (r >> 4) * 2 + (c >> 5), rr = r & 15, cc = c & 31, ob = rr * 64 + cc * 2; return st * 1024 + (ob ^ (((ob >> 9) & 1) << 5)); }
__host__ __device__ __forceinline__ void stage_rc(int b, int& R, int& C) { const int st = b / 1024, sb = b % 1024, swz = sb ^ (((sb >> 9) & 1) << 5); R = (st >> 1) * 16 + swz / 64; C = (st & 1) * 32 + (swz % 64) / 2; }
__host__ __device__ __forceinline__ int perm32(int rho) { const int n = rho >> 4, i = rho & 15; return 8 * (i >> 2) + 4 * n + (i & 3); }

struct Unit { int pm, pn; };
struct Gemm { const bf16_t* A; const bf16_t* Bt; int M, N, K, lda; };

struct StaticOrder {
    int nM, nN, nwg, G, c;
    __host__ __device__ void init(int M, int N, int G_, int c_) { nM = M / BM; nN = N / BM; nwg = nM * nN; G = G_; c = c_; }
    __host__ __device__ bool next(int i, Unit& u) const {
        const long L = (long)i * G + c; if (L >= nwg) return false;
        int wgid = (int)L; { const int q = nwg / NXCD, r = nwg % NXCD, xcd = wgid % NXCD, off = wgid / NXCD; wgid = (xcd < r ? xcd * (q + 1) : r * (q + 1) + (xcd - r) * q) + off; }
        const int nig = WGM * nN, gid = wgid / nig, fm = gid * WGM, gsz = (nM - fm) < WGM ? (nM - fm) : WGM;
        u.pm = fm + ((wgid % nig) % gsz); u.pn = (wgid % nig) / gsz; return true;
    }
    __device__ __forceinline__ void a_ready(const Unit&) const {}
    __device__ __forceinline__ void done(const Unit&) const {}
};

__device__ __forceinline__ unsigned cvt_pk_bf16(float lo, float hi) { unsigned r; asm volatile("v_cvt_pk_bf16_f32 %0, %1, %2" : "=v"(r) : "v"(lo), "v"(hi)); return r; }
__device__ __forceinline__ float silu_f(float g) { return g * __builtin_amdgcn_rcpf(1.0f + __expf(-g)); }

struct EpiF32 {
    static constexpr bool PERM = false, AFTER_DRAIN = false;
    float* C; int ldc;
    __device__ __forceinline__ void operator()(const f32x4 (&acc)[2][2][4][2], const Unit& u, int wr, int wc, int fr, int fq) const {
        const int row0 = u.pm * BM + wr * 64 + fr, col0 = u.pn * BM + wc * 32 + 4 * fq;
#pragma unroll
        for (int ai = 0; ai < 2; ++ai)
#pragma unroll
            for (int m = 0; m < 4; ++m) { float* rowp = C + (size_t)(row0 + ai * HALF + m * 16) * ldc + col0;
#pragma unroll
                for (int bj = 0; bj < 2; ++bj)
#pragma unroll
                    for (int n = 0; n < 2; ++n) *(f32x4*)(rowp + bj * HALF + n * 16) = acc[ai][bj][m][n]; }
    }
};
struct EpiBf16 {
    static constexpr bool PERM = true, AFTER_DRAIN = false;
    bf16_t* O; int ldc;
    __device__ __forceinline__ void operator()(const f32x4 (&acc)[2][2][4][2], const Unit& u, int wr, int wc, int fr, int fq) const {
        const int row0 = u.pm * BM + wr * 64 + fr, col0 = u.pn * BM + wc * 32 + 8 * fq;
#pragma unroll
        for (int ai = 0; ai < 2; ++ai)
#pragma unroll
            for (int m = 0; m < 4; ++m) { bf16_t* rowp = O + (size_t)(row0 + ai * HALF + m * 16) * ldc + col0;
#pragma unroll
                for (int bj = 0; bj < 2; ++bj) { const f32x4 v0 = acc[ai][bj][m][0], v1 = acc[ai][bj][m][1];
                    u32x4 w; w.x = cvt_pk_bf16(v0[0], v0[1]); w.y = cvt_pk_bf16(v0[2], v0[3]); w.z = cvt_pk_bf16(v1[0], v1[1]); w.w = cvt_pk_bf16(v1[2], v1[3]);
                    *(u32x4*)(rowp + bj * HALF) = w; } }
    }
};
struct EpiBiasSilu {
    static constexpr bool PERM = true, AFTER_DRAIN = false;
    bf16_t* O; int ldc; const float* bias;
    __device__ __forceinline__ void operator()(const f32x4 (&acc)[2][2][4][2], const Unit& u, int wr, int wc, int fr, int fq) const {
        const int row0 = u.pm * BM + wr * 64 + fr, col0 = u.pn * BM + wc * 32 + 8 * fq;
        f32x4 bv[2][2];
#pragma unroll
        for (int bj = 0; bj < 2; ++bj)
#pragma unroll
            for (int n = 0; n < 2; ++n) bv[bj][n] = *(const f32x4*)(bias + col0 + bj * HALF + 4 * n);
#pragma unroll
        for (int ai = 0; ai < 2; ++ai)
#pragma unroll
            for (int m = 0; m < 4; ++m) { bf16_t* rowp = O + (size_t)(row0 + ai * HALF + m * 16) * ldc + col0;
#pragma unroll
                for (int bj = 0; bj < 2; ++bj) { f32x4 v0 = acc[ai][bj][m][0] + bv[bj][0], v1 = acc[ai][bj][m][1] + bv[bj][1];
#pragma unroll
                    for (int j = 0; j < 4; ++j) { v0[j] = silu_f(v0[j]); v1[j] = silu_f(v1[j]); }
                    u32x4 w; w.x = cvt_pk_bf16(v0[0], v0[1]); w.y = cvt_pk_bf16(v0[2], v0[3]); w.z = cvt_pk_bf16(v1[0], v1[1]); w.w = cvt_pk_bf16(v1[2], v1[3]);
                    *(u32x4*)(rowp + bj * HALF) = w; } }
    }
};
struct EpiSwiglu {
    static constexpr bool PERM = true, AFTER_DRAIN = false;
    bf16_t* O; int ldc;
    __device__ __forceinline__ void operator()(const f32x4 (&acc)[2][2][4][2], const Unit& u, int wr, int wc, int fr, int fq) const {
        const int row0 = u.pm * BM + wr * 64 + fr, col0 = u.pn * HALF + wc * 32 + 8 * fq;
#pragma unroll
        for (int ai = 0; ai < 2; ++ai)
#pragma unroll
            for (int m = 0; m < 4; ++m) { bf16_t* rowp = O + (size_t)(row0 + ai * HALF + m * 16) * ldc + col0;
                f32x4 h0, h1;
#pragma unroll
                for (int j = 0; j < 4; ++j) { h0[j] = silu_f(acc[ai][0][m][0][j]) * acc[ai][1][m][0][j]; h1[j] = silu_f(acc[ai][0][m][1][j]) * acc[ai][1][m][1][j]; }
                u32x4 w; w.x = cvt_pk_bf16(h0[0], h0[1]); w.y = cvt_pk_bf16(h0[2], h0[3]); w.z = cvt_pk_bf16(h1[0], h1[1]); w.w = cvt_pk_bf16(h1[2], h1[3]);
                *(u32x4*)rowp = w; }
    }
};
struct EpiNsaQkv {
    static constexpr bool PERM = true, AFTER_DRAIN = false;
    bf16_t* qraw; bf16_t* qrot; bf16_t* kv;
    size_t kvstride; const float* cs; const float* sn;
    __device__ __forceinline__ void operator()(const f32x4 (&acc)[2][2][4][2], const Unit& u, int wr, int wc, int fr, int fq) const {
        const int d0 = wc * 16 + 4 * fq;
#pragma unroll
        for (int bj = 0; bj < 2; ++bj) {
            const int hb = 2 * u.pn + bj;
            const bool isq = hb < 16; const int t = (hb - 16) >> 2, g = (hb - 16) & 3; const bool rope = isq || t == 2 || t == 4;
#pragma unroll
            for (int ai = 0; ai < 2; ++ai)
#pragma unroll
                for (int m = 0; m < 4; ++m) {
                    const int row = u.pm * BM + ai * HALF + wr * 64 + m * 16 + fr, b = row >> 11, s = row & 2047;
                    const f32x4 v0 = acc[ai][bj][m][0], v1 = acc[ai][bj][m][1];
                    f32x4 r0 = v0, r1 = v1;
                    if (rope) { const f32x4 c = *(const f32x4*)(cs + s * 64 + d0), sv = *(const f32x4*)(sn + s * 64 + d0); r0 = v0 * c - v1 * sv; r1 = v1 * c + v0 * sv; }
                    u32x2 w0, w1; w0.x = cvt_pk_bf16(r0[0], r0[1]); w0.y = cvt_pk_bf16(r0[2], r0[3]); w1.x = cvt_pk_bf16(r1[0], r1[1]); w1.y = cvt_pk_bf16(r1[2], r1[3]);
                    if (isq) {
                        u32x2 p0, p1; p0.x = cvt_pk_bf16(v0[0], v0[1]); p0.y = cvt_pk_bf16(v0[2], v0[3]); p1.x = cvt_pk_bf16(v1[0], v1[1]); p1.y = cvt_pk_bf16(v1[2], v1[3]);
                        bf16_t* pr = qraw + (size_t)row * 2048 + hb * 128 + d0; *(u32x2*)pr = p0; *(u32x2*)(pr + 64) = p1;
                        bf16_t* po = qrot + ((size_t)((b * 16 + hb) * 2048 + s)) * 128 + d0; *(u32x2*)po = w0; *(u32x2*)(po + 64) = w1;
                    } else {
                        bf16_t* pk = kv + (size_t)t * kvstride + ((size_t)((b * 4 + g) * 2048 + s)) * 128 + d0; *(u32x2*)pk = w0; *(u32x2*)(pk + 64) = w1;
                    }
                }
        }
    }
};

template <class Epi, class Sched, bool ALIGN_EPI = false, bool SP2 = false>
__device__ __forceinline__ void gemm_phase(PG8_LAS unsigned char* lds, const Gemm g, const Sched& S, const Epi& E, int wave_s) {
    int ws_l = wave_s; asm volatile("" : "+s"(ws_l)); int lane_l; asm volatile("v_mbcnt_lo_u32_b32 %0, -1, 0\n\tv_mbcnt_hi_u32_b32 %0, -1, %0" : "=v"(lane_l)); const int tid_l = ws_l * 64 + lane_l;
    const int tid = tid_l, wid = __builtin_amdgcn_readfirstlane(tid >> 6), lane = tid & 63, wr = wid >> 2, wc = wid & 3, fr = lane & 15, fq = lane >> 4;
    const int K = g.K, nt = K / BK;
    unsigned voffA[2], voffB[2];
#pragma unroll
    for (int i = 0; i < 2; ++i) { int R, C; stage_rc(tid * 16 + i * 8192, R, C); const int Rb = Epi::PERM ? ((R & ~31) + perm32(R & 31)) : R;
        voffA[i] = (unsigned)(R * g.lda + C) * 2u; voffB[i] = (unsigned)(Rb * K + C) * 2u; }
    const size_t kstep = (size_t)(BK * 2);
    const size_t hstepA = (size_t)HALF * g.lda * 2, hstepB = (size_t)HALF * K * 2;
    const size_t tstepA = 2 * hstepA, tstepB = 2 * hstepB;
    const unsigned ldsw = (unsigned)wid * 1024u;
    const int aoff = lds_byte(wr * 64 + fr, fq * 8), boff = lds_byte(wc * 32 + fr, fq * 8);
#define PG8_SA(b, h) (((b) * 2 + (h)) * HTB)
#define PG8_SB(b, h) ((4 + (b) * 2 + (h)) * HTB)
#define PG8_STAGE(bufoff, gbase, voff) do { _Pragma("unroll") for (int _i = 0; _i < 2; ++_i) \
        __builtin_amdgcn_global_load_lds((const unsigned*)((const char*)(gbase) + (voff)[_i]), (PG8_LAS unsigned*)(lds + (bufoff) + ldsw + _i * 8192), 16, 0, 0); } while (0)
#define PG8_LDA(dst, b, h) do { _Pragma("unroll") for (int m = 0; m < 4; ++m) _Pragma("unroll") for (int k = 0; k < 2; ++k) dst[m][k] = *(const PG8_LAS bf16x8*)(lds + PG8_SA(b, h) + aoff + m * 2048 + k * 1024); } while (0)
#define PG8_LDB(dst, b, h) do { _Pragma("unroll") for (int n = 0; n < 2; ++n) _Pragma("unroll") for (int k = 0; k < 2; ++k) dst[n][k] = *(const PG8_LAS bf16x8*)(lds + PG8_SB(b, h) + boff + n * 2048 + k * 1024); } while (0)
#define PG8_MMA(ai, bj, At, Bt) do { __builtin_amdgcn_s_setprio(1); _Pragma("unroll") for (int m = 0; m < 4; ++m) _Pragma("unroll") for (int n = 0; n < 2; ++n) _Pragma("unroll") for (int k = 0; k < 2; ++k) \
        acc[ai][bj][m][n] = __builtin_amdgcn_mfma_f32_16x16x32_bf16(Bt[n][k], At[m][k], acc[ai][bj][m][n], 0, 0, 0); __builtin_amdgcn_s_setprio(0); } while (0)
#define PG8_WAIT_V(n) asm volatile("s_waitcnt vmcnt(" #n ")" ::: "memory")
#define PG8_WAIT_L(n) asm volatile("s_waitcnt lgkmcnt(" #n ")" ::: "memory")
#define PG8_BAR __builtin_amdgcn_s_barrier()
#define PG8_SCHED __builtin_amdgcn_sched_barrier(0)
    Unit cur, nxt; int ui = 0;
    if (!S.next(0, cur)) return;
    f32x4 acc[2][2][4][2];
#pragma unroll
    for (int a = 0; a < 2; ++a)
#pragma unroll
        for (int b = 0; b < 2; ++b)
#pragma unroll
            for (int m = 0; m < 4; ++m)
#pragma unroll
                for (int n = 0; n < 2; ++n) acc[a][b][m][n] = (f32x4){0.f, 0.f, 0.f, 0.f};
    bf16x8 At[4][2], B0[2][2], B1[2][2];
    const char* cA = (const char*)g.A + (size_t)cur.pm * tstepA; const char* cB = (const char*)g.Bt + (size_t)cur.pn * tstepB;
    S.a_ready(cur);
    if constexpr (SP2) {
        PG8_STAGE(PG8_SB(0, 0), cB, voffB); PG8_STAGE(PG8_SB(0, 1), cB + hstepB, voffB); PG8_STAGE(PG8_SA(0, 0), cA, voffA); PG8_STAGE(PG8_SA(0, 1), cA + hstepA, voffA);
        if (wr == 1) PG8_BAR;
        PG8_WAIT_V(2); PG8_BAR;
        PG8_STAGE(PG8_SB(1, 0), cB + kstep, voffB); PG8_STAGE(PG8_SA(1, 0), cA + kstep, voffA); PG8_STAGE(PG8_SB(1, 1), cB + hstepB + kstep, voffB);
        PG8_WAIT_V(6); PG8_BAR;
    } else {
        PG8_STAGE(PG8_SB(0, 0), cB, voffB); PG8_STAGE(PG8_SA(0, 0), cA, voffA); PG8_STAGE(PG8_SB(0, 1), cB + hstepB, voffB); PG8_STAGE(PG8_SA(0, 1), cA + hstepA, voffA);
        if (wr == 1) PG8_BAR;
        PG8_WAIT_V(4); PG8_BAR;
        PG8_STAGE(PG8_SB(1, 0), cB + kstep, voffB); PG8_STAGE(PG8_SA(1, 0), cA + kstep, voffA); PG8_STAGE(PG8_SB(1, 1), cB + hstepB + kstep, voffB);
        PG8_WAIT_V(6); PG8_BAR;
    }
    for (;;) {
        const bool has_next = S.next(ui + 1, nxt);
        const char* nA = has_next ? (const char*)g.A + (size_t)nxt.pm * tstepA : cA; const char* nB = has_next ? (const char*)g.Bt + (size_t)nxt.pn * tstepB : cB;
        for (int t = 0; t < nt; t += 2) {
            const bool last = (t == nt - 2);
            const char* a1 = cA + (size_t)(t + 1) * kstep;
            const char* a2 = last ? nA : cA + (size_t)(t + 2) * kstep; const char* b2 = last ? nB : cB + (size_t)(t + 2) * kstep;
            const char* a3 = a2 + kstep; const char* b3 = b2 + kstep;
            if (last && has_next) S.a_ready(nxt);
            if constexpr (SP2) {
            PG8_LDB(B0, 0, 0); PG8_LDB(B1, 0, 1); PG8_SCHED; PG8_LDA(At, 0, 0); PG8_STAGE(PG8_SA(1, 1), a1 + hstepA, voffA);
            PG8_WAIT_V(8); PG8_WAIT_L(0); PG8_BAR; PG8_MMA(0, 0, At, B0); PG8_MMA(0, 1, At, B1); PG8_BAR; PG8_SCHED;
            PG8_LDA(At, 0, 1); PG8_STAGE(PG8_SB(0, 0), b2, voffB); PG8_STAGE(PG8_SB(0, 1), b2 + hstepB, voffB); PG8_STAGE(PG8_SA(0, 0), a2, voffA);
            PG8_WAIT_V(8); PG8_WAIT_L(0); PG8_BAR; PG8_MMA(1, 0, At, B0); PG8_MMA(1, 1, At, B1); PG8_BAR; PG8_SCHED;
            PG8_LDB(B0, 1, 0); PG8_LDB(B1, 1, 1); PG8_SCHED; PG8_LDA(At, 1, 0); PG8_STAGE(PG8_SA(0, 1), a2 + hstepA, voffA);
            PG8_WAIT_V(8); PG8_WAIT_L(0); PG8_BAR; PG8_MMA(0, 0, At, B0); PG8_MMA(0, 1, At, B1); PG8_BAR; PG8_SCHED;
            PG8_LDA(At, 1, 1); PG8_STAGE(PG8_SB(1, 0), b3, voffB); PG8_STAGE(PG8_SB(1, 1), b3 + hstepB, voffB); PG8_STAGE(PG8_SA(1, 0), a3, voffA);
            PG8_WAIT_V(8); PG8_WAIT_L(0); PG8_BAR; PG8_MMA(1, 0, At, B0); PG8_MMA(1, 1, At, B1); PG8_BAR; PG8_SCHED;
            } else {
            PG8_LDB(B0, 0, 0); PG8_SCHED; PG8_LDA(At, 0, 0); PG8_STAGE(PG8_SA(1, 1), a1 + hstepA, voffA);
            PG8_WAIT_L(8); PG8_BAR; PG8_WAIT_L(0); PG8_MMA(0, 0, At, B0); PG8_BAR; PG8_SCHED;
            PG8_LDB(B1, 0, 1); PG8_STAGE(PG8_SB(0, 0), b2, voffB);
            PG8_BAR; PG8_WAIT_L(0); PG8_MMA(0, 1, At, B1); PG8_BAR;
            PG8_LDA(At, 0, 1); PG8_STAGE(PG8_SA(0, 0), a2, voffA);
            PG8_BAR; PG8_WAIT_L(0); PG8_MMA(1, 0, At, B0); PG8_BAR; PG8_SCHED;
            PG8_STAGE(PG8_SB(0, 1), b2 + hstepB, voffB);
            PG8_WAIT_V(6); PG8_BAR; PG8_MMA(1, 1, At, B1); PG8_BAR;
            PG8_LDB(B0, 1, 0); PG8_SCHED; PG8_LDA(At, 1, 0); PG8_STAGE(PG8_SA(0, 1), a2 + hstepA, voffA);
            PG8_WAIT_L(8); PG8_BAR; PG8_WAIT_L(0); PG8_MMA(0, 0, At, B0); PG8_BAR; PG8_SCHED;
            PG8_LDB(B1, 1, 1); PG8_STAGE(PG8_SB(1, 0), b3, voffB);
            PG8_BAR; PG8_WAIT_L(0); PG8_MMA(0, 1, At, B1); PG8_BAR;
            PG8_LDA(At, 1, 1); PG8_STAGE(PG8_SA(1, 0), a3, voffA);
            PG8_BAR; PG8_WAIT_L(0); PG8_MMA(1, 0, At, B0); PG8_BAR; PG8_SCHED;
            PG8_STAGE(PG8_SB(1, 1), b3 + hstepB, voffB);
            PG8_WAIT_V(6); PG8_BAR; PG8_MMA(1, 1, At, B1); PG8_BAR;
            }
        }
        if constexpr (ALIGN_EPI) { if (wr == 0) PG8_BAR; }
        if constexpr (!Epi::AFTER_DRAIN) { E(acc, cur, wr, wc, fr, fq); S.done(cur); }
        if (!has_next) break;
#pragma unroll
        for (int a = 0; a < 2; ++a)
#pragma unroll
            for (int b = 0; b < 2; ++b)
#pragma unroll
                for (int m = 0; m < 4; ++m)
#pragma unroll
                    for (int n = 0; n < 2; ++n) acc[a][b][m][n] = (f32x4){0.f, 0.f, 0.f, 0.f};
        cur = nxt; cA = nA; cB = nB; ++ui;
        if constexpr (ALIGN_EPI) { if (wr == 1) PG8_BAR; }
    }
    PG8_WAIT_V(0);
    if constexpr (!ALIGN_EPI) { if (wr == 0) PG8_BAR; }
    PG8_BAR;
    if constexpr (Epi::AFTER_DRAIN) { E.fused(acc, cur, wr, wc, fr, fq, lds, wid, lane); S.done(cur); }
#undef PG8_SA
#undef PG8_SB
#undef PG8_STAGE
#undef PG8_LDA
#undef PG8_LDB
#undef PG8_MMA
#undef PG8_WAIT_V
#undef PG8_WAIT_L
#undef PG8_BAR
#undef PG8_SCHED
}
}

namespace att {
typedef unsigned short bf16;
typedef short bf16x8 __attribute__((ext_vector_type(8)));
typedef short s16x4 __attribute__((ext_vector_type(4)));
typedef float f32x16 __attribute__((ext_vector_type(16)));
typedef float f32x4 __attribute__((ext_vector_type(4)));
typedef unsigned u32x4 __attribute__((ext_vector_type(4)));
constexpr int D = 128, NW = 8, QBLK = 32, KVBLK = 64, QB = NW * QBLK, SKV = 2048;
constexpr float SCALE = 0.08838834764831845f, THR = 8.f;
constexpr int SHM_V = KVBLK * D * 2, SHM_K = KVBLK * D * 2;
constexpr int LDS_BYTES = 2 * SHM_V + 2 * SHM_K + NW * 64 * 4;

#define KSWZ(row, colB) ((row) * 256 + ((colB) ^ (((row) & 7) << 4)))
#define SBAR() __builtin_amdgcn_sched_barrier(0)
__device__ __forceinline__ int v_st(int k, int c) { const int kk = (k & ~0xC) | ((k & 4) << 1) | ((k & 8) >> 1); return ((kk >> 3) * 4 + (c >> 5)) * 512 + ((kk & 7) * 32 + (c & 31)) * 2; }
__device__ __forceinline__ int v_rd_base(int lane) { return ((lane & 3) << 3) | (((lane >> 2) & 3) << 6) | (((lane >> 4) & 1) << 5) | (((lane >> 5) & 1) << 8); }
constexpr int v_rd_off(int d0, int ks, int half) { return d0 * 512 + ks * 4096 + half * 2048; }
__device__ __forceinline__ int crow(int r, int hi) { return (r & 3) + 8 * (r >> 2) + 4 * hi; }
__device__ __forceinline__ unsigned cvtpk(float lo, float hi) { unsigned r; asm volatile("v_cvt_pk_bf16_f32 %0, %1, %2" : "=v"(r) : "v"(lo), "v"(hi)); return r; }
__device__ __forceinline__ void swap32(unsigned& a, unsigned& b) { asm volatile("s_nop 1\n\tv_permlane32_swap_b32 %0, %1\n\ts_nop 1" : "+v"(a), "+v"(b)); }
__device__ __forceinline__ bf16x8 load8(const bf16* p) { return *reinterpret_cast<const bf16x8*>(p); }
__device__ __forceinline__ void mask_tile(f32x16& p0, f32x16& p1, int dq, unsigned W) {
    const float NEG = -__builtin_inff();
#pragma unroll
    for (int r = 0; r < 16; ++r) {
        const int c = (r & 3) + 8 * (r >> 2);
        if ((unsigned)(dq - c) >= W) p0[r] = NEG;
        if ((unsigned)(dq - c - 32) >= W) p1[r] = NEG;
    }
}
__device__ __forceinline__ void selmask_tile(f32x16& p0, f32x16& p1, bool on) {
    const float NEG = -__builtin_inff();
#pragma unroll
    for (int r = 0; r < 16; ++r) { p0[r] = on ? p0[r] : NEG; p1[r] = on ? p1[r] : NEG; }
}
__device__ __forceinline__ void partialSM(f32x16& p0, f32x16& p1, float& m_reg, float& mn, float& alpha) {
    float pmax = p0[0]; for (int r = 1; r < 16; ++r) pmax = fmaxf(pmax, p0[r]); for (int r = 0; r < 16; ++r) pmax = fmaxf(pmax, p1[r]);
    { unsigned pa_ = __float_as_uint(pmax), pb_ = pa_; swap32(pa_, pb_); pmax = fmaxf(__uint_as_float(pa_), __uint_as_float(pb_)); }
    constexpr float C2 = 1.4426950408889634f * SCALE;
    if (__builtin_expect(__all((pmax - m_reg) * SCALE <= THR), 1)) { mn = m_reg; alpha = 1.f; }
    else { mn = fmaxf(m_reg, pmax); alpha = __builtin_amdgcn_exp2f((m_reg - mn) * C2); m_reg = mn; }
    const float mnL = -mn * C2;
    for (int r = 0; r < 16; ++r) p0[r] = fmaf(p0[r], C2, mnL); for (int r = 0; r < 16; ++r) p1[r] = fmaf(p1[r], C2, mnL);
    for (int r = 0; r < 16; ++r) p0[r] = __builtin_amdgcn_exp2f(p0[r]);
}
__device__ __forceinline__ void finishSM(f32x16& p0, f32x16& p1, float alpha, float& l_reg, bf16x8& pa0, bf16x8& pa1, bf16x8& pa2, bf16x8& pa3) {
    for (int r = 0; r < 16; ++r) p1[r] = __builtin_amdgcn_exp2f(p1[r]);
    float ps = 0; for (int r = 0; r < 16; ++r) ps += p0[r]; for (int r = 0; r < 16; ++r) ps += p1[r];
    { unsigned pa_ = __float_as_uint(ps), pb_ = pa_; swap32(pa_, pb_); ps = __uint_as_float(pa_) + __uint_as_float(pb_); }
    l_reg = l_reg * alpha + ps;
#define PK4(P, B_, OUT) do { unsigned a0 = cvtpk(P[B_+0], P[B_+1]), a1 = cvtpk(P[B_+2], P[B_+3]);                          \
        unsigned b0 = cvtpk(P[B_+4], P[B_+5]), b1 = cvtpk(P[B_+6], P[B_+7]);                                             \
        swap32(a0, b0); swap32(a1, b1); \
        u32x4 w = {a0, a1, b0, b1}; OUT = *reinterpret_cast<bf16x8*>(&w); } while (0)
    PK4(p0, 0, pa0); PK4(p0, 8, pa1); PK4(p1, 0, pa2); PK4(p1, 8, pa3);
#undef PK4
}
template <int KB, bool SK>
__device__ __forceinline__ void qkt(f32x16& p0, f32x16& p1, const char* K_lds, int r32, int hi, const bf16x8* qr, bool act) {
    if (SK && !act) { const float NEG = -__builtin_inff();
#pragma unroll
        for (int r = 0; r < 16; ++r) { p0[r] = NEG; p1[r] = NEG; } return; }
    p0 = f32x16{}; p1 = f32x16{};
    const char* kb[4];
#pragma unroll
    for (int dd = 0; dd < 4; ++dd) kb[dd] = K_lds + KB * SHM_K + KSWZ(r32, (dd * 16 + hi * 8) * 2);
#pragma unroll
    for (int d0 = 0; d0 < 8; ++d0) { const char* a = kb[d0 & 3] + (d0 >> 2) * 128;
        bf16x8 b0 = *reinterpret_cast<const bf16x8*>(a);
        bf16x8 b1 = *reinterpret_cast<const bf16x8*>(a + 32 * 256);
        p0 = __builtin_amdgcn_mfma_f32_32x32x16_bf16(b0, qr[d0], p0, 0, 0, 0);
        p1 = __builtin_amdgcn_mfma_f32_32x32x16_bf16(b1, qr[d0], p1, 0, 0, 0); }
}
template <int VB, bool SK>
__device__ __forceinline__ void pv_tile(f32x16* o, int vb0, bf16x8 pa0, bf16x8 pa1, bf16x8 pa2, bf16x8 pa3, bool act) {
    if (SK && !act) return;
#define TRRD(dst, off) asm volatile("ds_read_b64_tr_b16 %0, %1 offset:%2" : "=&v"(dst) : "v"(vb0), "i"(off) : "memory")
#define PV_D0(d0) do { s16x4 l0, l1, l2, l3, h0, h1, h2, h3; constexpr int b_ = VB * SHM_V + v_rd_off(d0, 0, 0); \
        TRRD(l0, b_); TRRD(h0, b_ + 2048); TRRD(l1, b_ + 4096); TRRD(h1, b_ + 6144); TRRD(l2, b_ + 8192); TRRD(h2, b_ + 10240); TRRD(l3, b_ + 12288); TRRD(h3, b_ + 14336); \
        asm volatile("s_waitcnt lgkmcnt(0)" ::: "memory"); SBAR();   \
        o[d0] = __builtin_amdgcn_mfma_f32_32x32x16_bf16(pa0, (bf16x8){l0[0], l0[1], l0[2], l0[3], h0[0], h0[1], h0[2], h0[3]}, o[d0], 0, 0, 0);   \
        o[d0] = __builtin_amdgcn_mfma_f32_32x32x16_bf16(pa1, (bf16x8){l1[0], l1[1], l1[2], l1[3], h1[0], h1[1], h1[2], h1[3]}, o[d0], 0, 0, 0);   \
        o[d0] = __builtin_amdgcn_mfma_f32_32x32x16_bf16(pa2, (bf16x8){l2[0], l2[1], l2[2], l2[3], h2[0], h2[1], h2[2], h2[3]}, o[d0], 0, 0, 0);   \
        o[d0] = __builtin_amdgcn_mfma_f32_32x32x16_bf16(pa3, (bf16x8){l3[0], l3[1], l3[2], l3[3], h3[0], h3[1], h3[2], h3[3]}, o[d0], 0, 0, 0); } while (0)
    PV_D0(0); PV_D0(1); PV_D0(2); PV_D0(3);
#undef PV_D0
#undef TRRD
}

struct BlockRef { const bf16* Q; const bf16* K; const bf16* V; int P0, row0; };
struct Seam { bf16x8 qr[8]; bf16x8 st_v0, st_v1, st_k0, st_k1; };
__device__ __forceinline__ int swa_jlo(int P0, int W) { const int lowk = P0 - W + 1; return lowk > 0 ? lowk / KVBLK : 0; }
#define VMW() asm volatile("s_waitcnt vmcnt(0)" ::: "memory")
#define VMWN(n) asm volatile("s_waitcnt vmcnt(%0)" :: "i"(n) : "memory")
#define LDG16(base, off) (*reinterpret_cast<const bf16x8*>((const char*)(base) + (off)))
#define SLOAD_H(Kp, Vp, k0) do { const char* kb_ = (const char*)(Kp) + (size_t)(k0) * (D * 2); const char* vb_ = (const char*)(Vp) + (size_t)(k0) * (D * 2);   \
                         S.st_v0 = LDG16(vb_, toff); S.st_v1 = LDG16(vb_ + 32 * D * 2, toff); S.st_k0 = LDG16(kb_, toff); S.st_k1 = LDG16(kb_ + 32 * D * 2, toff); } while (0)
#define SWRITE_HK(bf) do { *(bf16x8*)(K_lds + (bf) * SHM_K + kws) = S.st_k0; *(bf16x8*)(K_lds + (bf) * SHM_K + kws + 32 * 256) = S.st_k1; } while (0)
#define SWRITE_HV(bf) do { *(bf16x8*)(V_lds + (bf) * SHM_V + vst0) = S.st_v0; *(bf16x8*)(V_lds + (bf) * SHM_V + vst1) = S.st_v1; } while (0)
#define SWRITE_H(bf) do { SWRITE_HV(bf); SWRITE_HK(bf); } while (0)
__device__ __forceinline__ void att_prime(const BlockRef& cur, int W, char* lds, Seam& S, int tid) {
    asm volatile("" : "+v"(tid));
    const int wid = __builtin_amdgcn_readfirstlane(tid >> 6), lane = tid & 63, r32 = lane & 31, hi = lane >> 5;
    const int sr = tid >> 4, sc = (tid & 15) * 8, kws = KSWZ(sr, sc * 2); char* K_lds = lds + 2 * SHM_V;
    const unsigned toff = (unsigned)(sr * D + sc) * 2u, qoffb = (unsigned)((wid * QBLK + r32) * D + hi * 8) * 2u;
    const int kb0 = swa_jlo(cur.P0, W) * KVBLK;
    for (int d0 = 0; d0 < 8; ++d0) S.qr[d0] = LDG16((const char*)cur.Q + d0 * 32, qoffb);
    SLOAD_H(cur.K, cur.V, kb0); VMW(); SWRITE_HK(0);
    __syncthreads();
}
template <int MODE>
__device__ __forceinline__ void att_block(const BlockRef& cur, const BlockRef& nxt, int Wn, char* lds, Seam& S, int tid,
                                          int head, const float* gate, float* oacc, bf16* obf, const unsigned* msk  ) {
    constexpr bool SK = (MODE == 1);
    constexpr int W = (MODE == 1) ? 512 : (1 << 24);
    asm volatile("" : "+v"(tid));
    const int wid = __builtin_amdgcn_readfirstlane(tid >> 6), lane = tid & 63, r32 = lane & 31, hi = lane >> 5;
    const int j_lo = swa_jlo(cur.P0, W);
    int j_hi = (cur.P0 + QB - 1) / KVBLK + 1; if (j_hi > SKV / KVBLK) j_hi = SKV / KVBLK;
    const int NT = j_hi - j_lo;
    const int kbn = swa_jlo(nxt.P0, Wn) * KVBLK;
    const int qlo = cur.P0 + wid * QBLK, qm = qlo + r32 - 4 * hi;
    unsigned selbits = 0xffffffffu; if (MODE == 0) selbits = msk[qlo + r32];
    char* V_lds = lds; char* K_lds = lds + 2 * SHM_V;
    float* ws = (float*)(lds + 2 * SHM_V + 2 * SHM_K) + wid * 64; float* li_l = ws, * al_l = ws + 32;
    float m_reg = -1e30f, l_reg = 0; f32x16 o[4] = {};
    const int sr = tid >> 4, sc = (tid & 15) * 8, vst0 = v_st(sr, sc), vst1 = v_st(32 + sr, sc), kws = KSWZ(sr, sc * 2);
    const unsigned toff = (unsigned)(sr * D + sc) * 2u, qoffb = (unsigned)((wid * QBLK + r32) * D + hi * 8) * 2u;
    const int vb0 = (int)(uintptr_t)V_lds + v_rd_base(lane);
    const bf16* Kh = cur.K; const bf16* Vh = cur.V;
#define RESC(a) do { if (__any((a) < 1.f)) { if (hi == 0) al_l[r32] = (a); asm volatile("s_waitcnt lgkmcnt(0)" ::: "memory");              \
                     for (int d_ = 0; d_ < 4; ++d_) for (int r = 0; r < 16; ++r) o[d_][r] *= al_l[crow(r, hi)]; } } while (0)
#define KBASE(t) ((j_lo + (t)) * KVBLK)
#define ACT(t) (KBASE(t) <= qlo + QBLK - 1 && KBASE(t) + KVBLK - 1 >= qlo - W + 1)
#define MASKT(P0_, P1_, t) do { const int kb_ = KBASE(t); if ((!SK || ACT(t)) && (kb_ + KVBLK - 1 > qlo || kb_ <= qlo + QBLK - 1 - W)) mask_tile(P0_, P1_, qm - kb_, (unsigned)W); \
        if (MODE == 0) selmask_tile(P0_, P1_, ((selbits >> (j_lo + (t))) & 1u) != 0u); } while (0)
    constexpr int NQL = 8;
#define SEAM_K0() do { VMWN(NQL); SWRITE_HK(0); SBAR(); } while (0)
    f32x16 pA0, pA1, pB0, pB1; float mnA, mnB, alA, alB; bf16x8 pa0, pa1, pa2, pa3;
    SWRITE_HV(0); SBAR();
    if (NT > 1) { SLOAD_H(Kh, Vh, KBASE(1)); }
    SBAR(); qkt<0, SK>(pA0, pA1, K_lds, r32, hi, S.qr, ACT(0));
    MASKT(pA0, pA1, 0); partialSM(pA0, pA1, m_reg, mnA, alA);
    if (NT > 1) { VMW(); SWRITE_H(1); }
    __syncthreads();
#define HALF_STEP(PX0, PX1, mnX, alX, PY0, PY1, alY, t, KB, VB, SB) do {                                                      \
        SBAR(); qkt<KB, SK>(PX0, PX1, K_lds, r32, hi, S.qr, ACT(t));                                             \
        finishSM(PY0, PY1, alY, l_reg, pa0, pa1, pa2, pa3); SBAR();                                                           \
        if ((t) + 1 < NT) { SLOAD_H(Kh, Vh, KBASE((t) + 1)); SBAR(); }                                               \
        pv_tile<VB, SK>(o, vb0, pa0, pa1, pa2, pa3, ACT((t) - 1)); MASKT(PX0, PX1, (t)); partialSM(PX0, PX1, m_reg, mnX, alX);                                        \
        __syncthreads();                                                                                                      \
        if ((t) + 1 < NT) { VMW(); SWRITE_H(SB); }                                                                          \
        RESC(alX); __syncthreads(); } while (0)
    for (int t = 1; t + 1 < NT; t += 2) {
        HALF_STEP(pB0, pB1, mnB, alB, pA0, pA1, alA, t, 1, 0, 0);
        HALF_STEP(pA0, pA1, mnA, alA, pB0, pB1, alB, t + 1, 0, 1, 1);
    }
    const bool even = (NT & 1) == 0;
    if (even) { SBAR(); qkt<1, SK>(pB0, pB1, K_lds, r32, hi, S.qr, ACT(NT - 1)); SBAR(); }
    SLOAD_H(nxt.K, nxt.V, kbn); SBAR();
#pragma unroll
    for (int d0 = 0; d0 < 8; ++d0) S.qr[d0] = LDG16((const char*)nxt.Q + d0 * 32, qoffb);
    SBAR();
    finishSM(pA0, pA1, alA, l_reg, pa0, pa1, pa2, pa3); SBAR();
    pv_tile<0, SK>(o, vb0, pa0, pa1, pa2, pa3, ACT(even ? NT - 2 : NT - 1));
    if (even) { MASKT(pB0, pB1, NT - 1); partialSM(pB0, pB1, m_reg, mnB, alB); __syncthreads(); RESC(alB);
        finishSM(pB0, pB1, alB, l_reg, pa0, pa1, pa2, pa3); SBAR(); pv_tile<1, SK>(o, vb0, pa0, pa1, pa2, pa3, ACT(NT - 1)); }
    SBAR(); SEAM_K0();
    if (hi == 0) li_l[r32] = l_reg; asm volatile("s_waitcnt lgkmcnt(0)" ::: "memory");
    float rli[16];
    const unsigned rowt = (unsigned)(cur.row0 + wid * QBLK + 4 * hi);
#pragma unroll
    for (int r = 0; r < 16; ++r) { const unsigned gro = (rowt + (unsigned)((r & 3) + 8 * (r >> 2))) * 192u + (unsigned)(head * 12 + 4 + 4 * MODE);
        rli[r] = __builtin_amdgcn_rcpf(li_l[crow(r, hi)]) * *(const float*)((const char*)gate + gro); }
#pragma unroll
    for (int r = 0; r < 16; ++r) { const unsigned ro = ((rowt + (unsigned)((r & 3) + 8 * (r >> 2))) * 2048u + (unsigned)(head * 128 + r32)) * 4u;
#pragma unroll
        for (int d0 = 0; d0 < 4; ++d0) { const float v = o[d0][r] * rli[r]; float* pa = (float*)((char*)oacc + ro + d0 * 128);
            if (MODE == 0) { *pa += v; }
            else { const float tot = *pa + v; const float vn = __builtin_bit_cast(float, __builtin_amdgcn_ds_swizzle(__builtin_bit_cast(int, tot), (1 << 10) | 0x1f));
                   if ((r32 & 1) == 0) *(unsigned*)((char*)obf + (ro >> 1) + d0 * 64) = cvtpk(tot, vn); } } }
    __syncthreads();
#undef RESC
#undef KBASE
#undef ACT
#undef MASKT
#undef SEAM_K0
#undef HALF_STEP
}
#undef LDG16
#undef VMW
#undef VMWN
#undef SLOAD_H
#undef SWRITE_HK
#undef SWRITE_HV
#undef SWRITE_H

__device__ __forceinline__ void imp_item(char* lds, int tid, int b, int g, int tblk, const bf16* qraw, const bf16* kc  , const bf16* vc, const float* gate, float* oacc, unsigned* maskp  ) {
    asm volatile("" : "+v"(tid));
    const int wid = __builtin_amdgcn_readfirstlane(tid >> 6), lane = tid & 63, r32 = lane & 31, hi = lane >> 5;
    char* V_lds = lds; char* K_lds = lds + 2 * SHM_V;
    float* BT = (float*)(lds + 4 * SHM_V) + wid * 2048;
    { const int sr = tid >> 4, sc = (tid & 15) * 8, kws = KSWZ(sr, sc * 2), vst0 = v_st(sr, sc), vst1 = v_st(32 + sr, sc); const unsigned toff = (unsigned)(sr * D + sc) * 2u;
#pragma unroll
      for (int kt = 0; kt < 2; ++kt) { const char* kb_ = (const char*)kc + (size_t)(64 * kt) * (D * 2); const char* vb_ = (const char*)vc + (size_t)(64 * kt) * (D * 2);
          const bf16x8 k0 = *(const bf16x8*)(kb_ + toff), k1 = *(const bf16x8*)(kb_ + 32 * D * 2 + toff), v0 = *(const bf16x8*)(vb_ + toff), v1 = *(const bf16x8*)(vb_ + 32 * D * 2 + toff);
          *(bf16x8*)(K_lds + kt * SHM_K + kws) = k0; *(bf16x8*)(K_lds + kt * SHM_K + kws + 32 * 256) = k1; *(bf16x8*)(V_lds + kt * SHM_V + vst0) = v0; *(bf16x8*)(V_lds + kt * SHM_V + vst1) = v1; } }
    __syncthreads();
    const int vb0 = (int)(uintptr_t)V_lds + v_rd_base(lane);
    constexpr float C2 = 1.4426950408889634f * SCALE; const float NEG = -__builtin_inff();
#pragma nounroll
    for (int st = 0; st < 4; ++st) {
        const int tb = tblk * 256 + st * 64 + wid * 8;
        const int t = tb + (r32 >> 2), head = g * 4 + (r32 & 3); const unsigned rowq = (unsigned)(b * SKV + t);
        bf16x8 qr[8];
#pragma unroll
        for (int d0 = 0; d0 < 8; ++d0) qr[d0] = *(const bf16x8*)((const char*)qraw + ((size_t)rowq * 2048 + head * 128 + d0 * 16 + hi * 8) * 2);
        f32x16 pA0, pA1, pB0, pB1;
        qkt<0, false>(pA0, pA1, K_lds, r32, hi, qr, true); qkt<1, false>(pB0, pB1, K_lds, r32, hi, qr, true);
        const int cmax = (t - 31) >> 4;
        float mx = NEG;
#pragma unroll
        for (int r = 0; r < 16; ++r) { const int kk = crow(r, hi);
            pA0[r] = (kk <= cmax) ? pA0[r] : NEG; pA1[r] = (kk + 32 <= cmax) ? pA1[r] : NEG; pB0[r] = (kk + 64 <= cmax) ? pB0[r] : NEG; pB1[r] = (kk + 96 <= cmax) ? pB1[r] : NEG;
            mx = fmaxf(fmaxf(mx, fmaxf(pA0[r], pA1[r])), fmaxf(pB0[r], pB1[r])); }
        { unsigned a_ = __float_as_uint(mx), b_ = a_; swap32(a_, b_); mx = fmaxf(__uint_as_float(a_), __uint_as_float(b_)); }
        const float mL = (cmax >= 0) ? -mx * C2 : 0.f; float ps = 0.f;
#pragma unroll
        for (int r = 0; r < 16; ++r) { pA0[r] = __builtin_amdgcn_exp2f(fmaf(pA0[r], C2, mL)); pA1[r] = __builtin_amdgcn_exp2f(fmaf(pA1[r], C2, mL)); pB0[r] = __builtin_amdgcn_exp2f(fmaf(pB0[r], C2, mL)); pB1[r] = __builtin_amdgcn_exp2f(fmaf(pB1[r], C2, mL));
            ps += (pA0[r] + pA1[r]) + (pB0[r] + pB1[r]); }
        { unsigned a_ = __float_as_uint(ps), b_ = a_; swap32(a_, b_); ps = __uint_as_float(a_) + __uint_as_float(b_); }
        const float inv = ps > 0.f ? 1.0f / ps : 0.f;
        pA0 = pA0 * inv; pA1 = pA1 * inv; pB0 = pB0 * inv; pB1 = pB1 * inv;
        float* Bp = BT + r32 * 32; float* Tp = BT + 1024 + r32 * 32;
#pragma unroll
        for (int gq = 0; gq < 4; ++gq) {
            Bp[2 * gq + hi] = (pA0[4 * gq] + pA0[4 * gq + 1]) + (pA0[4 * gq + 2] + pA0[4 * gq + 3]); Tp[2 * gq + hi] = pA0[4 * gq + 3];
            Bp[8 + 2 * gq + hi] = (pA1[4 * gq] + pA1[4 * gq + 1]) + (pA1[4 * gq + 2] + pA1[4 * gq + 3]); Tp[8 + 2 * gq + hi] = pA1[4 * gq + 3];
            Bp[16 + 2 * gq + hi] = (pB0[4 * gq] + pB0[4 * gq + 1]) + (pB0[4 * gq + 2] + pB0[4 * gq + 3]); Tp[16 + 2 * gq + hi] = pB0[4 * gq + 3];
            Bp[24 + 2 * gq + hi] = (pB1[4 * gq] + pB1[4 * gq + 1]) + (pB1[4 * gq + 2] + pB1[4 * gq + 3]); Tp[24 + 2 * gq + hi] = pB1[4 * gq + 3]; }
        f32x16 o[4] = {};
        { bf16x8 pa0, pa1, pa2, pa3;
#define PK4I(P, B_, OUT) do { unsigned a0 = cvtpk(P[B_+0], P[B_+1]), a1 = cvtpk(P[B_+2], P[B_+3]), b0 = cvtpk(P[B_+4], P[B_+5]), b1 = cvtpk(P[B_+6], P[B_+7]); \
        swap32(a0, b0); swap32(a1, b1); u32x4 w_ = {a0, a1, b0, b1}; OUT = *reinterpret_cast<bf16x8*>(&w_); } while (0)
          PK4I(pA0, 0, pa0); PK4I(pA0, 8, pa1); PK4I(pA1, 0, pa2); PK4I(pA1, 8, pa3); pv_tile<0, false>(o, vb0, pa0, pa1, pa2, pa3, true);
          PK4I(pB0, 0, pa0); PK4I(pB0, 8, pa1); PK4I(pB1, 0, pa2); PK4I(pB1, 8, pa3); pv_tile<1, false>(o, vb0, pa0, pa1, pa2, pa3, true);
#undef PK4I
        }
#pragma unroll
        for (int r = 0; r < 16; ++r) { const int rp = crow(r, hi); const unsigned rowo = (unsigned)(b * SKV + tb + (rp >> 2)); const int hd = g * 4 + (rp & 3);
            const float gt = *(const float*)((const char*)gate + (rowo * 48u + (unsigned)(hd * 3)) * 4u); const unsigned ro = (rowo * 2048u + (unsigned)(hd * 128 + r32)) * 4u;
#pragma unroll
            for (int d0 = 0; d0 < 4; ++d0) *(float*)((char*)oacc + ro + d0 * 128) = o[d0][r] * gt; }
        asm volatile("s_waitcnt lgkmcnt(0)" ::: "memory");
#pragma unroll 1
        for (int pp = 0; pp < 4; ++pp) {
            const int tl = 2 * pp + hi, tt = tb + tl, j = r32; float imp = 0.f;
#pragma unroll
            for (int hh = 0; hh < 4; ++hh) { imp += BT[(4 * tl + hh) * 32 + j]; if (j > 0) imp += BT[1024 + (4 * tl + hh) * 32 + j - 1]; }
            const int qb = tt >> 6; const bool causal = j <= qb, forced = (j == 0) || (causal && j > qb - 2);
            const float val = forced ? 1e9f : (causal ? imp : -1.0f);
            int rank = 0;
#pragma unroll
            for (int o2 = 0; o2 < 32; ++o2) { const float vo = __builtin_bit_cast(float, __builtin_amdgcn_ds_bpermute((o2 + 32 * hi) * 4, __builtin_bit_cast(int, val))); rank += (vo > val || (vo == val && o2 < j)) ? 1 : 0; }
            const bool sel = (rank < 16) && (val >= 0.f);
            const unsigned long long bal = __ballot(sel);
            if (r32 == 0) maskp[tt] = hi ? (unsigned)(bal >> 32) : (unsigned)bal;
        }
        asm volatile("s_waitcnt lgkmcnt(0)" ::: "memory");
    }
    __syncthreads();
}
#undef KSWZ
#undef SBAR
}

constexpr int NWAVES = 8;
constexpr int NB = 8, S = 2048, D = 2048, M = NB * S, FF = 5632, NMODC = 9 * D, DEPTH = 4;
constexpr int NSA_SRC = 5168, NSA_N = 5120, ML_SRC = 6160, ML_N = 6144;
constexpr float RMS_EPS = 1e-6f;

constexpr size_t MiB = 1u << 20;
constexpr size_t WS_CTL = 0, CTL_ZERO_BYTES = 1 * MiB;
constexpr size_t WS_MOD = 1 * MiB;
constexpr size_t WS_ROPE = 4 * MiB;
constexpr size_t WS_CBIAS = 5 * MiB;
constexpr size_t WS_MASK = 6 * MiB;
constexpr size_t WS_GATE = 7 * MiB;
constexpr size_t WS_KCVC = 10 * MiB;
constexpr size_t WS_CHID = 14 * MiB;
constexpr size_t WS_WC2 = 24 * MiB;
constexpr size_t WS_WG = 23 * MiB;
constexpr size_t WS_W = 32 * MiB;
constexpr size_t W_FFIN = 44 * MiB, W_FFOUT = 22 * MiB, W_NSAIN = 20 * MiB, W_CW1 = 4 * MiB, W_SQ = 8 * MiB, W_MLIN = 24 * MiB;
constexpr size_t WS_W_FFIN = WS_W;
constexpr size_t WS_W_FFOUT = WS_W_FFIN + 8 * W_FFIN;
constexpr size_t WS_W_NSAIN = WS_W_FFOUT + 8 * W_FFOUT;
constexpr size_t WS_W_CW1 = WS_W_NSAIN + 2 * W_NSAIN;
constexpr size_t WS_W_NSAOUT = WS_W_CW1 + 4 * W_CW1;
constexpr size_t WS_W_MLIN = WS_W_NSAOUT + 2 * W_SQ;
constexpr size_t WS_W_MLOUT = WS_W_MLIN + 2 * W_MLIN;
constexpr size_t WS_H = WS_W_MLOUT + 2 * W_SQ;
constexpr size_t WS_HID = WS_H + 64 * MiB;
constexpr size_t WS_Y = WS_HID + 176 * MiB;
constexpr size_t WS_O = WS_Y + 128 * MiB;
constexpr size_t WS_QRAW = WS_O + 64 * MiB, WS_QROT = WS_QRAW + 64 * MiB;
constexpr size_t WS_KV = WS_QROT + 64 * MiB;
constexpr size_t KV_STRIDE = 16 * MiB / 2;
constexpr size_t WS_OACC = WS_KV + 97 * MiB;
constexpr size_t WS_MLQ = WS_OACC + 128 * MiB;
constexpr size_t WS_END = WS_MLQ + 192 * MiB;
static_assert(WS_H == (32 + 352 + 176 + 40 + 16 + 16 + 48 + 16) * MiB, "weight map");

constexpr int CW_BAR = 4096;

constexpr int RING_BYTES = 131072;
constexpr int LDSCTL_OFF = RING_BYTES, MISC_OFF = LDSCTL_OFF + 320;
constexpr int LDS_BYTES = 147456;

#define GAS __attribute__((address_space(1)))
#define LAS __attribute__((address_space(3)))
typedef unsigned short bf16;
typedef float f32x4 __attribute__((ext_vector_type(4)));
typedef float f32x2 __attribute__((ext_vector_type(2)));
typedef unsigned v4u __attribute__((ext_vector_type(4)));
typedef unsigned v2u __attribute__((ext_vector_type(2)));
#define LDS_WAIT() asm volatile("s_waitcnt lgkmcnt(0)" ::: "memory")
__device__ __forceinline__ unsigned f2bf(float f) { unsigned u = __builtin_bit_cast(unsigned, f); return (u + 0x7fffu + ((u >> 16) & 1u)) >> 16; }
__device__ __forceinline__ unsigned pk2(float lo, float hi) { return f2bf(lo) | (f2bf(hi) << 16); }
__device__ __forceinline__ float bf2f(unsigned b) { return __builtin_bit_cast(float, b << 16); }
__device__ __forceinline__ float bflo(unsigned w) { return __builtin_bit_cast(float, w << 16); }
__device__ __forceinline__ float bfhi(unsigned w) { return __builtin_bit_cast(float, w & 0xffff0000u); }
template <int K> __device__ __forceinline__ float xor_lane(float v) { return __builtin_bit_cast(float, __builtin_amdgcn_ds_swizzle(__builtin_bit_cast(int, v), (K << 10) | 0x1f)); }
__device__ __forceinline__ void swap32(unsigned& a, unsigned& b) { asm volatile("s_nop 1\n\tv_permlane32_swap_b32 %0, %1\n\ts_nop 1" : "+v"(a), "+v"(b)); }
__device__ __forceinline__ float wave_sum(float v) {
    v += xor_lane<1>(v); v += xor_lane<2>(v); v += xor_lane<4>(v); v += xor_lane<8>(v); v += xor_lane<16>(v);
    unsigned a = __builtin_bit_cast(unsigned, v), c = a; swap32(a, c);
    return __builtin_bit_cast(float, a) + __builtin_bit_cast(float, c);
}
__device__ __forceinline__ float wave_max(float v) {
    v = fmaxf(v, xor_lane<1>(v)); v = fmaxf(v, xor_lane<2>(v)); v = fmaxf(v, xor_lane<4>(v)); v = fmaxf(v, xor_lane<8>(v)); v = fmaxf(v, xor_lane<16>(v));
    unsigned a = __builtin_bit_cast(unsigned, v), c = a; swap32(a, c);
    return fmaxf(__builtin_bit_cast(float, a), __builtin_bit_cast(float, c));
}

#define XB_TMO      128
#define XB_XCNT(j)  (256  + 64 * (j))
#define XB_XSUB(j)  (1280 + 64 * (j))
#define XB_XGEN(j)  (2304 + 64 * (j))
#define XB_TOP      3328
#define XB_TOPGEN   3392
#define XCD_BAR_WORDS 3456
#define XB_SPIN_CAP (1u << 22)
__device__ __forceinline__ unsigned xb_ld(unsigned* p)              { return __hip_atomic_load(p, __ATOMIC_RELAXED, __HIP_MEMORY_SCOPE_AGENT); }
__device__ __forceinline__ unsigned xb_add(unsigned* p, unsigned v) { return __hip_atomic_fetch_add(p, v, __ATOMIC_RELAXED, __HIP_MEMORY_SCOPE_AGENT); }
__device__ __forceinline__ unsigned xb_xcc_id() { return (unsigned)__builtin_amdgcn_s_getreg((3 << 11) | 20) & 0xFu; }
#define XB_SPIN(cond, bar) do { unsigned _sp = 0; while (cond) { __builtin_amdgcn_s_sleep(1); \
    if ((++_sp & 255u) == 0u) { if (xb_ld(&(bar)[XB_TMO])) break; if (_sp > XB_SPIN_CAP) { atomicAdd(&(bar)[XB_TMO], 1u); break; } } } } while (0)
__device__ __forceinline__ int lane_id();
struct XcdBarrier { unsigned* bar; unsigned x; volatile LAS unsigned* st; int w; };
__device__ __forceinline__ XcdBarrier xcd_barrier_post(unsigned* bar, volatile LAS unsigned* st, int wave_s) {
    XcdBarrier b; b.bar = bar; b.x = xb_xcc_id(); b.st = st; b.w = wave_s;
    if (wave_s == 0 && lane_id() == 0) (void)xb_add(&bar[XB_XCNT(b.x)], 1u);
    return b;
}
__device__ __forceinline__ void xcd_barrier_complete(unsigned* bar, unsigned x, unsigned& nloc, unsigned& nx) {
    const unsigned G = gridDim.x * gridDim.y * gridDim.z;
    unsigned sum, cnt, mine, sp = 0u;
    for (;;) {
        sum = 0u; cnt = 0u; mine = 0u;
#pragma unroll
        for (unsigned j = 0; j < 16; ++j) { const unsigned c = xb_ld(&bar[XB_XCNT(j)]); sum += c; cnt += (c > 0u) ? 1u : 0u; mine = (j == x) ? c : mine; }
        if (sum == G) break;
        __builtin_amdgcn_s_sleep(1);
        if ((++sp & 255u) == 0u) { if (xb_ld(&bar[XB_TMO])) break; if (sp > XB_SPIN_CAP) { atomicAdd(&bar[XB_TMO], 1u); break; } }
    }
    nloc = mine > 0u ? mine : 1u; nx = cnt > 0u ? cnt : 1u;
}
__device__ __forceinline__ void xcd_barrier(const XcdBarrier& b) {
    asm volatile("s_waitcnt vmcnt(0)" ::: "memory");
    __syncthreads();
    if (b.w == 0 && lane_id() == 0) {
        size_t bz = 0; asm volatile("" : "+s"(bz)); unsigned* bar = b.bar + bz;
        __builtin_amdgcn_s_waitcnt(0);
        unsigned nloc = b.st[0], nx = b.st[1];
        if (nloc == 0u) { xcd_barrier_complete(bar, b.x, nloc, nx); b.st[0] = nloc; b.st[1] = nx; }
        const unsigned old = xb_add(&bar[XB_XSUB(b.x)], 1u);
        const unsigned gen = old / nloc;
        if (old + 1u == (gen + 1u) * nloc) {
            __builtin_amdgcn_fence(__ATOMIC_RELEASE, "agent");
            asm volatile("s_waitcnt vmcnt(0)" ::: "memory");
            const unsigned og = xb_add(&bar[XB_TOP], 1u);
            const unsigned tg = og / nx;
            if (og + 1u == (tg + 1u) * nx) xb_add(&bar[XB_TOPGEN], 1u);
            else XB_SPIN(xb_ld(&bar[XB_TOPGEN]) == tg, bar);
            __builtin_amdgcn_fence(__ATOMIC_ACQUIRE, "agent");
            xb_add(&bar[XB_XGEN(b.x)], 1u);
            asm volatile("s_waitcnt vmcnt(0)" ::: "memory");
        } else {
            XB_SPIN(xb_ld(&bar[XB_XGEN(b.x)]) == gen, bar);
            __builtin_amdgcn_fence(__ATOMIC_ACQUIRE, "agent");
            asm volatile("s_waitcnt vmcnt(0)" ::: "memory");
        }
    }
    __syncthreads();
}

struct Args { const float* in[20]; float* out; unsigned char* ws; int ph_lo, ph_hi; };
struct Frame {
    LAS unsigned char* lds;
    int tid, lane, wave, G, wg;
};

__device__ __forceinline__ void sincos_small(double x, double& s, double& c) {
    const double x2 = x * x; double ts = x, tc = 1.0; s = x; c = 1.0;
#pragma unroll
    for (int k = 1; k <= 12; ++k) { tc = -tc * x2 / (double)((2 * k - 1) * (2 * k)); ts = -ts * x2 / (double)((2 * k) * (2 * k + 1)); c += tc; s += ts; }
}
__device__ __forceinline__ void rope_table(const Frame& F, float* cs, float* sn, double r  ) {
    for (int idx = F.wg * 512 + F.tid; idx < S * 64; idx += F.G * 512) {
        const int pos = idx >> 6, i = idx & 63;
        double f = 1.0; for (int k = 0; k < i; ++k) f *= r;
        double bs, bc; sincos_small(f, bs, bc);
        double rs = 0.0, rc = 1.0;
        for (int bit = 0; bit < 11; ++bit) {
            if ((pos >> bit) & 1) { const double nc = rc * bc - rs * bs, ns = rc * bs + rs * bc; rc = nc; rs = ns; }
            const double c2 = bc * bc - bs * bs, s2 = 2.0 * bs * bc; bc = c2; bs = s2;
        }
        cs[idx] = (float)rc; sn[idx] = (float)rs;
    }
}
template <int MAP> __device__ __forceinline__ int colmap(int i, int col0, int cmax) {
    if (MAP == 1) { const int pn = i >> 8, half = (i >> 7) & 1, j = i & 127; return half * FF + 128 * pn + j; }
    if (MAP == 2) { const int hb = i >> 7, ii = i & 127; return hb * 128 + 64 * ((ii >> 2) & 1) + 4 * (ii >> 3) + (ii & 3); }
    if (MAP == 3) return i;
    const int c = col0 + i; return c < cmax ? c : cmax;
}
template <int MAP> __device__ __forceinline__ void conv_item(const float* W, int ldw, int K, int N, bf16* WT, LAS float* scr, int item, int lane, int col0, int cmax) {
    const int nblk = N / 32, kb = item / nblk, nb = item % nblk, k0 = 64 * kb, n0 = 32 * nb;
    const int scol = colmap<MAP>(n0 + (lane & 31), col0, cmax);
#pragma unroll 8
    for (int i = 0; i < 32; ++i) { const int kk = 2 * i + (lane >> 5); scr[kk * 33 + (lane & 31)] = W[(size_t)(k0 + kk) * ldw + scol]; }
    LDS_WAIT(); asm volatile("" ::: "memory");
    const int c = lane & 7;
#pragma unroll
    for (int j = 0; j < 4; ++j) { const int n = (lane >> 3) + 8 * j; const LAS float* s = scr + (8 * c) * 33 + n;
        v4u o; o.x = pk2(s[0 * 33], s[1 * 33]); o.y = pk2(s[2 * 33], s[3 * 33]); o.z = pk2(s[4 * 33], s[5 * 33]); o.w = pk2(s[6 * 33], s[7 * 33]);
        *(v4u*)(WT + (size_t)(n0 + n) * K + k0 + 8 * c) = o; }
    LDS_WAIT(); asm volatile("" ::: "memory");
}
template <int MAP> __device__ __forceinline__ void conv_item_v(const float* W, int ldw, int K, int N, bf16* WT, LAS float* scr, int item, int lane) {
    const int nblk = N / 64, kb = item / nblk, nb = item % nblk, k0 = 32 * kb, n0 = 64 * nb, c4 = (lane & 15) * 4, rs = lane >> 4;
    const int scol = colmap<MAP>(n0 + c4, 0, 0x7fffffff);
    f32x4 v[8];
#pragma unroll
    for (int i = 0; i < 8; ++i) v[i] = *(const f32x4*)(W + (size_t)(k0 + 4 * i + rs) * ldw + scol);
#pragma unroll
    for (int i = 0; i < 8; ++i) { LAS float* d = scr + (4 * i + rs) * 65 + c4; d[0] = v[i].x; d[1] = v[i].y; d[2] = v[i].z; d[3] = v[i].w; }
    LDS_WAIT(); asm volatile("" ::: "memory");
    const int c = lane & 3;
#pragma unroll
    for (int j = 0; j < 4; ++j) { const int n = (lane >> 2) + 16 * j; const LAS float* s = scr + (8 * c) * 65 + n;
        v4u o; o.x = pk2(s[0 * 65], s[1 * 65]); o.y = pk2(s[2 * 65], s[3 * 65]); o.z = pk2(s[4 * 65], s[5 * 65]); o.w = pk2(s[6 * 65], s[7 * 65]);
        *(v4u*)(WT + (size_t)(n0 + n) * K + k0 + 8 * c) = o; }
    LDS_WAIT(); asm volatile("" ::: "memory");
}
template <int MAP> __device__ __forceinline__ void conv_matrix_v(const Frame& F, const float* W, int ldw, int K, int N, bf16* WT) {
    LAS float* scr = (LAS float*)(F.lds + F.wave * 16384);
    const int gw = F.wg * NWAVES + F.wave, NGW = F.G * NWAVES, items = (K / 32) * (N / 64);
    for (int it = gw; it < items; it += NGW) conv_item_v<MAP>(W, ldw, K, N, WT, scr, it, F.lane);
}
template <int MAP> __device__ __forceinline__ void conv_matrix(const Frame& F, const float* W, int ldw, int K, int N, bf16* WT, int col0, int cmax) {
    LAS float* scr = (LAS float*)(F.lds + F.wave * 16384);
    const int gw = F.wg * NWAVES + F.wave, NGW = F.G * NWAVES, items = (K / 64) * (N / 32);
    for (int it = gw; it < items; it += NGW) conv_item<MAP>(W, ldw, K, N, WT, scr, it, F.lane, col0, cmax);
}
__device__ __forceinline__ void mod_phase(const Frame& F, const float* c, const float* mw, const float* mb, float* mod, int l0, int nl, int wg0, int nwg) {
    LAS float* ca = (LAS float*)F.lds;
    LAS float* red = (LAS float*)(F.lds + 65536);
    for (int i = F.tid; i < NB * D; i += 512) { const float v = c[i]; ca[i] = v / (1.0f + __expf(-v)); }
    __syncthreads();
    const int nunits = nl * (NMODC / 64);
    for (int u = F.wg - wg0; u < nunits; u += nwg) {
        const int l = l0 + u / (NMODC / 64), cb = u % (NMODC / 64), col = cb * 64 + F.lane;
        const float* wp = mw + (size_t)l * D * NMODC + col;
        float a0[8];
#pragma unroll
        for (int b = 0; b < 8; ++b) a0[b] = 0.f;
        const int kbeg = F.wave * 256;
#pragma unroll 16
        for (int k = kbeg; k < kbeg + 256; ++k) {
            const float w = wp[(size_t)k * NMODC];
#pragma unroll
            for (int b = 0; b < 8; ++b) a0[b] += ca[b * D + k] * w;
        }
#pragma unroll
        for (int b = 0; b < 8; ++b) red[(F.wave * 8 + b) * 64 + F.lane] = a0[b];
        __syncthreads();
        { const int b = F.tid >> 6, j = F.tid & 63; float s = 0.f;
#pragma unroll
            for (int w = 0; w < 8; ++w) s += red[(w * 8 + b) * 64 + j];
            mod[((size_t)l * NB + b) * NMODC + cb * 64 + j] = s + mb[(size_t)l * NMODC + cb * 64 + j]; }
        __syncthreads();
    }
}
__device__ __forceinline__ void cbias_phase(const Frame& F, const float* pe, const float* w1, float* cb) {
    const int u = F.wg - (F.G - 32); if (u < 0) return;
    const int lt = u >> 3, n = (u & 7) * 64 + F.lane; LAS float* red = (LAS float*)F.lds;
    const float* p = pe + (size_t)lt * 4096 + F.wave * 512; const float* w = w1 + ((size_t)lt * 4096 + F.wave * 512) * 512 + n;
    float acc = 0.f;
#pragma unroll 16
    for (int k = 0; k < 512; ++k) acc += p[k] * w[(size_t)k * 512];
    red[F.wave * 64 + F.lane] = acc;
    __syncthreads();
    if (F.wave == 0) { float s = 0.f;
#pragma unroll
        for (int w8 = 0; w8 < 8; ++w8) s += red[w8 * 64 + F.lane];
        cb[lt * 512 + n] = s; }
    __syncthreads();
}

struct ThinArgs { const float* xin; float* xout; const bf16* Y; float coef; const float* gate; const float* gpost; const float* gpre; const float* shift; const float* scale; bf16* H; int pend, pre; };
__device__ __forceinline__ void thin_phase(const Frame& F, const ThinArgs& a) {
    const int gw = F.wg * NWAVES + F.wave, NGW = F.G * NWAVES;
    for (int blk = gw; blk < M / 8; blk += NGW) {
        const int row0 = blk * 8, b = row0 >> 11; const size_t bo = (size_t)b * NMODC + 4 * F.lane;
        f32x4 va[8], vp[8], vs[8];
        if (a.pend) {
#pragma unroll
            for (int j = 0; j < 8; ++j) va[j] = *(const f32x4*)(a.gate + bo + 256 * j) * *(const f32x4*)(a.gpost + 4 * F.lane + 256 * j) * a.coef;
        }
        if (a.pre) {
#pragma unroll
            for (int j = 0; j < 8; ++j) { vp[j] = *(const f32x4*)(a.gpre + 4 * F.lane + 256 * j) * (*(const f32x4*)(a.scale + bo + 256 * j) + 1.0f); vs[j] = *(const f32x4*)(a.shift + bo + 256 * j); }
        }
#pragma unroll 2
        for (int r = 0; r < 8; ++r) {
            const size_t ro = (size_t)(row0 + r) * D + 4 * F.lane;
            f32x4 x[8];
#pragma unroll
            for (int j = 0; j < 8; ++j) x[j] = *(const f32x4*)(a.xin + ro + 256 * j);
            if (a.pend) {
                f32x4 y[8]; float ss = 0.f;
#pragma unroll
                for (int j = 0; j < 8; ++j) { const v2u yw = *(const v2u*)(a.Y + ro + 256 * j); y[j] = (f32x4){bflo(yw.x), bfhi(yw.x), bflo(yw.y), bfhi(yw.y)}; ss += (y[j].x * y[j].x + y[j].y * y[j].y) + (y[j].z * y[j].z + y[j].w * y[j].w); }
                const float rr = rsqrtf(wave_sum(ss) * (1.0f / D) + RMS_EPS);
#pragma unroll
                for (int j = 0; j < 8; ++j) x[j] = x[j] + (y[j] * rr) * va[j];
            }
#pragma unroll
            for (int j = 0; j < 8; ++j) *(f32x4*)(a.xout + ro + 256 * j) = x[j];
            if (a.pre) {
                float ss = 0.f;
#pragma unroll
                for (int j = 0; j < 8; ++j) ss += (x[j].x * x[j].x + x[j].y * x[j].y) + (x[j].z * x[j].z + x[j].w * x[j].w);
                const float rr = rsqrtf(wave_sum(ss) * (1.0f / D) + RMS_EPS);
#pragma unroll
                for (int j = 0; j < 8; ++j) { const f32x4 h = (x[j] * rr) * vp[j] + vs[j];
                    v2u w; w.x = pk2(h.x, h.y); w.y = pk2(h.z, h.w); *(v2u*)(a.H + ro + 256 * j) = w; }
            }
        }
    }
}

template <int MODE, int NT> __device__ __forceinline__ void thin_proj(const Frame& F, const bf16* H, const bf16* Wt, const float* gb, float* out, int ldo) {
    typedef short bf16x8v __attribute__((ext_vector_type(8)));
    const int gw = F.wg * NWAVES + F.wave, NGW = F.G * NWAVES, fr = F.lane & 15, fq = F.lane >> 4;
    for (int rt = gw; rt < M / 16; rt += NGW) {
        f32x4 acc[NT];
#pragma unroll
        for (int n = 0; n < NT; ++n) acc[n] = (f32x4){0.f, 0.f, 0.f, 0.f};
        const bf16* ap = H + (size_t)(rt * 16 + fr) * D + fq * 8; const bf16* bp = Wt + (size_t)fr * D + fq * 8;
#pragma unroll 8
        for (int k0 = 0; k0 < D; k0 += 32) {
            const bf16x8v a = *(const bf16x8v*)(ap + k0);
#pragma unroll
            for (int n = 0; n < NT; ++n) { const bf16x8v bv = *(const bf16x8v*)(bp + (size_t)n * 16 * D + k0); acc[n] = __builtin_amdgcn_mfma_f32_16x16x32_bf16(bv, a, acc[n], 0, 0, 0); }
        }
#pragma unroll
        for (int n = 0; n < NT; ++n) { f32x4 v = acc[n];
            if (MODE == 0) {
#pragma unroll
                for (int e = 0; e < 4; ++e) v[e] = 1.0f / (1.0f + __expf(-v[e])); }
            else { const f32x4 bb = *(const f32x4*)(gb + 4 * fq); v = v + bb;
                if (fq >= 2) {
#pragma unroll
                    for (int e = 0; e < 4; ++e) { const float ex = __expf(-fabsf(v[e])); const float l1p = ex < 0.01f ? ex * (1.0f - ex * (0.5f - ex * 0.33333334f)) : __logf(1.0f + ex); v[e] = fminf(v[e], 0.f) - l1p; } } }
            *(f32x4*)(out + (size_t)(rt * 16 + fr) * ldo + 16 * n + 4 * fq) = v; }
    }
}

__device__ __forceinline__ void cmp2_mfma(const Frame& F, const bf16* hid  , const bf16* w2t  , bf16* kcvc  ) {
    typedef short bf16x8v __attribute__((ext_vector_type(8)));
    const int gw = F.wg * NWAVES + F.wave, NGW = F.G * NWAVES, fr = F.lane & 15, fq = F.lane >> 4;
    for (int task = gw; task < 512; task += NGW) {
        const int t = task >> 8, rt = task & 255, row = rt * 16 + fr;
        f32x4 acc[8];
#pragma unroll
        for (int n = 0; n < 8; ++n) acc[n] = (f32x4){0.f, 0.f, 0.f, 0.f};
        const bf16* ap = hid + ((size_t)t * 4096 + row) * 512 + fq * 8; const bf16* bp = w2t + ((size_t)t * 128 + fr) * 512 + fq * 8;
#pragma unroll 2
        for (int k0 = 0; k0 < 512; k0 += 32) {
            const bf16x8v a = *(const bf16x8v*)(ap + k0);
#pragma unroll
            for (int n = 0; n < 8; ++n) { const bf16x8v bv = *(const bf16x8v*)(bp + (size_t)n * 16 * 512 + k0); acc[n] = __builtin_amdgcn_mfma_f32_16x16x32_bf16(bv, a, acc[n], 0, 0, 0); }
        }
        const bool zr = (row & 127) == 127;
#pragma unroll
        for (int n = 0; n < 8; ++n) { const f32x4 v = zr ? (f32x4){0.f, 0.f, 0.f, 0.f} : acc[n];
            *(v2u*)(kcvc + ((size_t)t * 4096 + row) * 128 + 16 * n + 4 * fq) = (v2u){pk2(v[0], v[1]), pk2(v[2], v[3])}; }
    }
}
__device__ __forceinline__ void imp_phase_mfma(const Frame& F, char* lds, const bf16* qraw, const bf16* kc, const bf16* vc, const float* gate, float* oacc, unsigned* mask) {
    const int vcu = (F.G % 8 == 0) ? (F.wg % 8) * (F.G / 8) + F.wg / 8 : F.wg;
    for (int v = vcu; v < 256; v += F.G) {
        const int bg = v >> 3, tblk = v & 7;
        att::imp_item(lds, F.tid, bg >> 2, bg & 3, tblk, qraw, kc + (size_t)bg * 128 * 128, vc + (size_t)bg * 128 * 128, gate, oacc, mask + bg * S);
    }
}
__device__ __forceinline__ void att_phase_mfma(const Frame& F, char* lds, const bf16* qrot, const bf16* kv, const float* gate, float* oacc, const unsigned* mask, bf16* O) {
    const int vcu = (F.G % 8 == 0) ? (F.wg % 8) * (F.G / 8) + F.wg / 8 : F.wg;
    for (int v = vcu; v < 256; v += F.G) {
        const int bg = v >> 3, r = (v >> 1) & 3, half = v & 1, b = bg >> 2, g = bg & 3, head = g * 4 + r;
        const unsigned qlist = half ? 0x5261u : 0x4370u;
        const bf16* Qh = qrot + (size_t)(b * 16 + head) * S * 128;
        const bf16* Ks = kv + 2 * KV_STRIDE + (size_t)bg * S * 128; const bf16* Vs = kv + 3 * KV_STRIDE + (size_t)bg * S * 128;
        const bf16* Kw = kv + 4 * KV_STRIDE + (size_t)bg * S * 128; const bf16* Vw = kv + 5 * KV_STRIDE + (size_t)bg * S * 128;
        const unsigned* msk = mask + bg * S;
        att::Seam Sm;
        { const int qb0 = qlist & 15; const att::BlockRef c0{Qh + (size_t)qb0 * 256 * 128, Ks, Vs, qb0 * 256, b * S + qb0 * 256}; att::att_prime(c0, 1 << 24, lds, Sm, F.tid); }
#pragma nounroll
        for (int i = 0; i < 4; ++i) {
            const int qb = (qlist >> (4 * i)) & 15, qbn = (qlist >> (4 * ((i + 1) & 3))) & 15;
            const att::BlockRef bs{Qh + (size_t)qb * 256 * 128, Ks, Vs, qb * 256, b * S + qb * 256};
            const att::BlockRef bw{Qh + (size_t)qb * 256 * 128, Kw, Vw, qb * 256, b * S + qb * 256};
            const att::BlockRef bn{Qh + (size_t)qbn * 256 * 128, Ks, Vs, qbn * 256, b * S + qbn * 256};
            att::att_block<0>(bs, bw, 512, lds, Sm, F.tid, head, gate, oacc, O, msk);
            att::att_block<1>(bw, bn, 1 << 24, lds, Sm, F.tid, head, gate, oacc, O, msk);
        }
    }
}

#define LBAR() do { asm volatile("s_waitcnt lgkmcnt(0)" ::: "memory"); __builtin_amdgcn_s_barrier(); asm volatile("" ::: "memory"); } while (0)
namespace mlc {
typedef short bf16x8 __attribute__((ext_vector_type(8)));
typedef short bf16x4 __attribute__((ext_vector_type(4)));
typedef float f32x16 __attribute__((ext_vector_type(16)));
constexpr int QS = 0, KS = 17408, KGT = 34816, VST = 53248, PS = 90112, VEC = 99328;
constexpr int QLD = 136, TLD = 72, HLD = 264;
__device__ __forceinline__ unsigned cvtpk(float lo, float hi) { unsigned r; asm volatile("v_cvt_pk_bf16_f32 %0, %1, %2" : "=v"(r) : "v"(lo), "v"(hi)); return r; }
__device__ __forceinline__ int crow(int r, int hi) { return (r & 3) + 8 * (r >> 2) + 4 * hi; }
}
__device__ __forceinline__ void mlstm_cell_mfma(const Frame& F, const bf16* qkvo  , const float* mlg  , const float* convw  , const float* convb, const float* mhg, bf16* O) {
    using namespace mlc;
    LAS unsigned char* L = F.lds; LAS float* V = (LAS float*)(L + VEC);
    const int w = F.wave, lane0 = F.lane, tid = F.tid;
    const int quarter = w >> 1, cp0 = (w & 1) * 64 + lane0;
    for (int item = F.wg; item < NB * 8; item += F.G) {
        const int b = item >> 3, h = item & 7;
        f32x16 Ct[4];
#pragma unroll
        for (int kt = 0; kt < 4; ++kt) Ct[kt] = f32x16{};
        if (tid < 256) V[1344 + tid] = 0.f;
        float m_prev = 0.f;
        const int qkcol0 = (cp0 < 64) ? (h * 128 + 2 * cp0) : (1024 + h * 128 + 2 * (cp0 - 64));
        const f32x2 cw0 = *(const f32x2*)(convw + qkcol0), cw1 = *(const f32x2*)(convw + 2048 + qkcol0), cw2 = *(const f32x2*)(convw + 4096 + qkcol0), cw3 = *(const f32x2*)(convw + 6144 + qkcol0), cbv = *(const f32x2*)(convb + qkcol0);
        const bf16* xb = qkvo + (size_t)b * S * 6144;
        unsigned xp[19], vq[16]; float gi_n = 0.f, gl_n = 0.f;
#define ML_ISSUE(cn, qc_, vc_) do { const int cn_ = (cn) < 32 ? (cn) : 31, r0n_ = cn_ * 64 + 16 * quarter; const bool hist_ = r0n_ >= 3;                    \
            const bf16* xh_ = xb + (size_t)(hist_ ? r0n_ - 3 : 0) * 6144; const bf16* xrn_ = xb + (size_t)r0n_ * 6144;                                       \
            { const unsigned h0_ = *(const unsigned*)(xh_ + (qc_)), h1_ = *(const unsigned*)(xh_ + 6144 + (qc_)), h2_ = *(const unsigned*)(xh_ + 2 * 6144 + (qc_)); \
              xp[0] = hist_ ? h0_ : 0u; xp[1] = hist_ ? h1_ : 0u; xp[2] = hist_ ? h2_ : 0u; }                                                                 \
            _Pragma("unroll") for (int ii_ = 0; ii_ < 16; ++ii_) xp[3 + ii_] = *(const unsigned*)((xrn_ + ii_ * 6144) + (qc_));                              \
            _Pragma("unroll") for (int ii_ = 0; ii_ < 16; ++ii_) vq[ii_] = *(const unsigned*)((xrn_ + ii_ * 6144) + (vc_)); } while (0)
        ML_ISSUE(0, (unsigned)qkcol0, (unsigned)(2048 + h * 256 + 2 * cp0));
#define ML_GATE_PREP(cn, ln_) do { LAS float* Vn_ = V + ((cn) & 1) * 512;                                                                      \
            const float ig = gi_n, lf = gl_n;                                                                                                \
            { const size_t grow = (size_t)(b * S + ((cn) < 31 ? (cn) * 64 + 64 : (cn) * 64) + (ln_)) * 16; gi_n = mlg[grow + h]; gl_n = mlg[grow + 8 + h]; }   \
            float bs = lf;                                                                                                                   \
            _Pragma("unroll") for (int d = 1; d < 64; d <<= 1) { const float o = __shfl_up(bs, d); if ((ln_) >= d) bs += o; }              \
            const float a = ig - bs; float A = a;                                                                                            \
            _Pragma("unroll") for (int d = 1; d < 64; d <<= 1) { const float o = __shfl_up(A, d); if ((ln_) >= d) A = fmaxf(A, o); }       \
            const float Mi = fmaxf(m_prev, A);                                                                                               \
            const float A63 = __shfl(A, 63), b63 = __shfl(bs, 63); const float M63 = fmaxf(m_prev, A63);                                   \
            Vn_[(ln_)] = bs; Vn_[64 + (ln_)] = a; Vn_[128 + (ln_)] = A; Vn_[192 + (ln_)] = Mi; Vn_[256 + (ln_)] = __expf(m_prev - Mi); Vn_[320 + (ln_)] = __expf(-(bs + Mi)); Vn_[384 + (ln_)] = __expf(a - M63); \
            if ((ln_) == 0) Vn_[448] = __expf(m_prev - M63);                                                                                \
            m_prev = b63 + M63; } while (0)
        if (w == 7) { const size_t g0 = (size_t)(b * S + lane0) * 16; gi_n = mlg[g0 + h]; gl_n = mlg[g0 + 8 + h]; ML_GATE_PREP(0, lane0); }
        LBAR();
#pragma nounroll
        for (int c = 0; c < 32; ++c) {
            const int t0 = c * 64, nb = c & 1;
            int lane = lane0; asm volatile("" : "+v"(lane));
            const int l31 = lane & 31, hi = lane >> 5, cp = (w & 1) * 64 + lane; LAS float* Vc = V + nb * 512;
            const int qkcol = (cp < 64) ? (h * 128 + 2 * cp) : (1024 + h * 128 + 2 * (cp - 64)); const unsigned vcol = (unsigned)(2048 + h * 256 + 2 * cp);
            {
                f32x2 x0 = (f32x2){bflo(xp[0]), bfhi(xp[0])}, x1 = (f32x2){bflo(xp[1]), bfhi(xp[1])}, x2 = (f32x2){bflo(xp[2]), bfhi(xp[2])};
                unsigned kga[8], kgb[8];
#pragma unroll
                for (int ii = 0; ii < 16; ++ii) {
                    const f32x2 x3 = (f32x2){bflo(xp[3 + ii]), bfhi(xp[3 + ii])}; f32x2 v = cw0 * x0 + cw1 * x1 + cw2 * x2 + cw3 * x3 + cbv;
                    v.x = v.x / (1.0f + __expf(-v.x)); v.y = v.y / (1.0f + __expf(-v.y));
                    x0 = x1; x1 = x2; x2 = x3; const int i = 16 * quarter + ii;
                    if (cp < 64) { *(LAS unsigned*)(L + QS + (i * QLD + 2 * cp) * 2) = pk2(v.x, v.y); }
                    else { const f32x2 kv = v * 0.08838834764831845f; *(LAS unsigned*)(L + KS + (i * QLD + 2 * (cp - 64)) * 2) = pk2(kv.x, kv.y);
                        const float gi = Vc[384 + i]; const unsigned ga = f2bf(kv.x * gi), gb = f2bf(kv.y * gi);
                        if (ii & 1) { kga[ii >> 1] |= ga << 16; kgb[ii >> 1] |= gb << 16; } else { kga[ii >> 1] = ga; kgb[ii >> 1] = gb; } }
                }
                if (cp >= 64) { const int d = 2 * (cp - 64);
#pragma unroll
                    for (int q4 = 0; q4 < 2; ++q4) { *(LAS v4u*)(L + KGT + (d * TLD + 16 * quarter + 8 * q4) * 2) = (v4u){kga[4 * q4], kga[4 * q4 + 1], kga[4 * q4 + 2], kga[4 * q4 + 3]};
                        *(LAS v4u*)(L + KGT + ((d + 1) * TLD + 16 * quarter + 8 * q4) * 2) = (v4u){kgb[4 * q4], kgb[4 * q4 + 1], kgb[4 * q4 + 2], kgb[4 * q4 + 3]}; } }
                unsigned va[8], vb[8];
#pragma unroll
                for (int ii = 0; ii < 16; ii += 2) { va[ii >> 1] = (vq[ii] & 0xffffu) | (vq[ii + 1] << 16); vb[ii >> 1] = (vq[ii] >> 16) | (vq[ii + 1] & 0xffff0000u); }
#pragma unroll
                for (int q4 = 0; q4 < 2; ++q4) { *(LAS v4u*)(L + VST + ((2 * cp) * TLD + 16 * quarter + 8 * q4) * 2) = (v4u){va[4 * q4], va[4 * q4 + 1], va[4 * q4 + 2], va[4 * q4 + 3]};
                    *(LAS v4u*)(L + VST + ((2 * cp + 1) * TLD + 16 * quarter + 8 * q4) * 2) = (v4u){vb[4 * q4], vb[4 * q4 + 1], vb[4 * q4 + 2], vb[4 * q4 + 3]}; }
                ML_ISSUE(c + 1, (unsigned)qkcol, vcol);
            }
            LBAR();
            v2u og[8]; f32x4 gn;
            if (w < 4) {
                const int jt = w & 1, it = w >> 1; f32x16 st = f32x16{};
#pragma unroll
                for (int s = 0; s < 8; ++s) {
                    const bf16x8 ka = *(const LAS bf16x8*)(L + KS + ((32 * jt + l31) * QLD + 16 * s + 8 * hi) * 2);
                    const bf16x8 qb = *(const LAS bf16x8*)(L + QS + ((32 * it + l31) * QLD + 16 * s + 8 * hi) * 2);
                    st = __builtin_amdgcn_mfma_f32_32x32x16_bf16(ka, qb, st, 0, 0, 0);
                }
                const int i = 32 * it + l31; const float Mi = Vc[192 + i]; float dsum = 0.f;
#pragma unroll
                for (int g4 = 0; g4 < 4; ++g4) {
                    float pv[4];
#pragma unroll
                    for (int e = 0; e < 4; ++e) { const int j = 32 * jt + 8 * g4 + 4 * hi + e; const float val = (j <= i) ? st[4 * g4 + e] * __expf(Vc[64 + j] - Mi) : 0.f; pv[e] = val; dsum += val; }
                    *(LAS v2u*)(L + PS + (i * TLD + 32 * jt + 8 * g4 + 4 * hi) * 2) = (v2u){cvtpk(pv[0], pv[1]), cvtpk(pv[2], pv[3])};
                }
                V[1024 + (jt * 2 + hi) * 64 + i] = dsum;
            } else {
                const LAS float* nv = V + 1344 + nb * 128; const float n0 = nv[lane], n1 = nv[lane + 64];
#pragma unroll 4
                for (int rr = 0; rr < 16; ++rr) { const int i = (w - 4) * 16 + rr;
                    const float q0 = bf2f(*(const LAS unsigned short*)(L + QS + (i * QLD + lane) * 2)), q1 = bf2f(*(const LAS unsigned short*)(L + QS + (i * QLD + lane + 64) * 2));
                    const float sdot = wave_sum(q0 * n0 + q1 * n1); if (lane == 0) V[1280 + i] = sdot; }
                if (w < 6) { const int k = (w - 4) * 64 + lane; float acc = 0.f;
#pragma unroll
                    for (int q8 = 0; q8 < 8; ++q8) { const v4u u = *(const LAS v4u*)(L + KGT + (k * TLD + 8 * q8) * 2); acc += bflo(u.x) + bfhi(u.x) + bflo(u.y) + bfhi(u.y) + bflo(u.z) + bfhi(u.z) + bflo(u.w) + bfhi(u.w); }
                    V[1344 + (nb ^ 1) * 128 + k] = Vc[448] * nv[k] + acc; }
                if (w == 7 && c < 31) ML_GATE_PREP(c + 1, lane);
            }
            LBAR();
            {
                bf16x8 bv[4];
#pragma unroll
                for (int js = 0; js < 4; ++js) bv[js] = *(const LAS bf16x8*)(L + VST + ((32 * w + l31) * TLD + 16 * js + 8 * hi) * 2);
                f32x16 ho[2];
#pragma unroll
                for (int it = 0; it < 2; ++it) {
                    f32x16 acc = f32x16{};
#pragma unroll
                    for (int kt = 0; kt < 4; ++kt)
#pragma unroll
                        for (int s = 0; s < 2; ++s) {
                            const bf16x4 qa = *(const LAS bf16x4*)(L + QS + ((32 * it + l31) * QLD + 32 * kt + 16 * s + 4 * hi) * 2);
                            const bf16x4 qb = *(const LAS bf16x4*)(L + QS + ((32 * it + l31) * QLD + 32 * kt + 16 * s + 8 + 4 * hi) * 2);
                            const bf16x8 aq = (bf16x8){qa[0], qa[1], qa[2], qa[3], qb[0], qb[1], qb[2], qb[3]};
                            const unsigned c0 = cvtpk(Ct[kt][8 * s + 0], Ct[kt][8 * s + 1]), c1 = cvtpk(Ct[kt][8 * s + 2], Ct[kt][8 * s + 3]), c2 = cvtpk(Ct[kt][8 * s + 4], Ct[kt][8 * s + 5]), c3 = cvtpk(Ct[kt][8 * s + 6], Ct[kt][8 * s + 7]);
                            const v4u cw = (v4u){c0, c1, c2, c3};
                            acc = __builtin_amdgcn_mfma_f32_32x32x16_bf16(aq, __builtin_bit_cast(bf16x8, cw), acc, 0, 0, 0);
                        }
#pragma unroll
                    for (int r = 0; r < 16; ++r) acc[r] *= Vc[256 + 32 * it + crow(r, hi)];
#pragma unroll
                    for (int js = 0; js < 4; ++js) { const bf16x8 pa = *(const LAS bf16x8*)(L + PS + ((32 * it + l31) * TLD + 16 * js + 8 * hi) * 2); acc = __builtin_amdgcn_mfma_f32_32x32x16_bf16(pa, bv[js], acc, 0, 0, 0); }
#pragma unroll
                    for (int r = 0; r < 16; ++r) { const int i = 32 * it + crow(r, hi); const float den = Vc[256 + i] * V[1280 + i] + (V[1024 + i] + V[1088 + i]) + (V[1152 + i] + V[1216 + i]);
                        acc[r] = acc[r] / fmaxf(fabsf(den), Vc[320 + i]); }
                    ho[it] = acc;
                }
#pragma unroll
                for (int rr = 0; rr < 8; ++rr) og[rr] = *(const v2u*)(qkvo + (size_t)(b * S + t0 + 8 * w + rr) * 6144 + 4096 + h * 256 + 4 * lane);
                gn = *(const f32x4*)(mhg + h * 256 + 4 * lane);
                const float adec = Vc[448];
#pragma unroll
                for (int kt = 0; kt < 4; ++kt) {
                    f32x16 cacc = Ct[kt] * adec;
#pragma unroll
                    for (int js = 0; js < 4; ++js) { const bf16x8 ka = *(const LAS bf16x8*)(L + KGT + ((32 * kt + l31) * TLD + 16 * js + 8 * hi) * 2); cacc = __builtin_amdgcn_mfma_f32_32x32x16_bf16(ka, bv[js], cacc, 0, 0, 0); }
                    Ct[kt] = cacc;
                }
                LBAR();
#pragma unroll
                for (int it = 0; it < 2; ++it)
#pragma unroll
                    for (int r = 0; r < 16; ++r) *(LAS unsigned short*)(L + QS + ((32 * it + crow(r, hi)) * HLD + 32 * w + l31) * 2) = (unsigned short)f2bf(ho[it][r]);
            }
            LBAR();
#pragma unroll
            for (int rr = 0; rr < 8; ++rr) {
                const int i = 8 * w + rr; const size_t grow = (size_t)(b * S + t0 + i);
                const v2u hw = *(const LAS v2u*)(L + QS + (i * HLD + 4 * lane) * 2);
                const float h0 = bflo(hw.x), h1 = bfhi(hw.x), h2 = bflo(hw.y), h3 = bfhi(hw.y);
                const float rstd = rsqrtf(wave_sum((h0 * h0 + h1 * h1) + (h2 * h2 + h3 * h3)) * (1.0f / 256.0f) + RMS_EPS);
                const v2u ow = og[rr];
                const float o0 = h0 * rstd * gn.x / (1.0f + __expf(-bflo(ow.x))), o1 = h1 * rstd * gn.y / (1.0f + __expf(-bfhi(ow.x))), o2 = h2 * rstd * gn.z / (1.0f + __expf(-bflo(ow.y))), o3 = h3 * rstd * gn.w / (1.0f + __expf(-bfhi(ow.y)));
                *(v2u*)(O + grow * 2048 + h * 256 + 4 * lane) = (v2u){pk2(o0, o1), pk2(o2, o3)};
            }
            LBAR();
        }
    }
#undef ML_ISSUE
#undef ML_GATE_PREP
}

__device__ __forceinline__ int lane_id() { int l; asm volatile("v_mbcnt_lo_u32_b32 %0, -1, 0\n\tv_mbcnt_hi_u32_b32 %0, -1, %0" : "=v"(l)); return l; }
__device__ __forceinline__ Frame mkframe(unsigned char* lds_generic, int wave_s) {
    Frame F; F.lds = (LAS unsigned char*)lds_generic; int w = wave_s; asm volatile("" : "+s"(w)); int t = w * 64 + lane_id(); asm volatile("" : "+v"(t));
    F.tid = t; F.lane = t & 63; F.wave = w; int g_ = gridDim.x, w_ = blockIdx.x; asm volatile("" : "+s"(g_), "+s"(w_)); F.G = g_; F.wg = w_; return F;
}
__device__ __forceinline__ const float* inptr(LAS const unsigned* tbl, int i) {
    const unsigned lo = __builtin_amdgcn_readfirstlane(tbl[2 * i]), hi = __builtin_amdgcn_readfirstlane(tbl[2 * i + 1]);
    return (const float*)(const GAS float*)(((unsigned long long)hi << 32) | lo);
}
#define INP(i) inptr((LAS const unsigned*)((LAS unsigned char*)lds + LDSCTL_OFF + 4096), (i))
#define WSL(name) size_t name##_z = 0; asm volatile("" : "+s"(name##_z)); unsigned char* name = args.ws + name##_z; int gdim = gridDim.x, wgi = blockIdx.x; asm volatile("" : "+s"(gdim), "+s"(wgi))
__device__ __forceinline__ void conv_jobs(const Frame& F, LAS const unsigned* itab, unsigned char* ws, unsigned long long mask, int wg0, int nwg) {
#define INPF(i) inptr(itab, (i))
    Frame Fc = F; Fc.wg = F.wg - wg0; Fc.G = nwg;
        LAS unsigned* jt = (LAS unsigned*)(F.lds + LDSCTL_OFF + 1024);
        if (F.tid < 36) {
            const int job = F.tid; const float* W; int ldw, K, N, map = 3, col0 = 0, cmax = 0x7fffffff; bf16* WT;
            if (job < 8) { const int l = job >> 1; W = ((job & 1) ? INPF(7) : INPF(5)) + (size_t)l * D * 2 * FF; ldw = 2 * FF; K = D; N = 2 * FF; WT = (bf16*)(ws + WS_W_FFIN + (size_t)job * W_FFIN); map = 1; }
            else if (job < 16) { const int q = job - 8, l = q >> 1; W = ((q & 1) ? INPF(8) : INPF(6)) + (size_t)l * FF * D; ldw = D; K = FF; N = D; WT = (bf16*)(ws + WS_W_FFOUT + (size_t)q * W_FFOUT); }
            else if (job < 18) { const int j = job - 16; W = INPF(9) + (size_t)j * D * NSA_SRC; ldw = NSA_SRC; K = D; N = NSA_N; WT = (bf16*)(ws + WS_W_NSAIN + (size_t)j * W_NSAIN); map = 2; }
            else if (job < 22) { const int q = job - 18; W = INPF(11) + (size_t)q * 4096 * 512; ldw = 512; K = 4096; N = 512; WT = (bf16*)(ws + WS_W_CW1 + (size_t)q * W_CW1); }
            else if (job < 24) { const int j = job - 22; W = INPF(13) + (size_t)j * D * D; ldw = D; K = D; N = D; WT = (bf16*)(ws + WS_W_NSAOUT + (size_t)j * W_SQ); }
            else if (job < 26) { const int j = job - 24; W = INPF(14) + (size_t)j * D * ML_SRC; ldw = ML_SRC; K = D; N = ML_N; WT = (bf16*)(ws + WS_W_MLIN + (size_t)j * W_MLIN); }
            else if (job < 28) { const int j = job - 26; W = INPF(19) + (size_t)j * D * D; ldw = D; K = D; N = D; WT = (bf16*)(ws + WS_W_MLOUT + (size_t)j * W_SQ); }
            else if (job < 30) { const int j = job - 28; W = INPF(9) + (size_t)j * D * NSA_SRC; ldw = NSA_SRC; K = D; N = 64; WT = (bf16*)(ws + WS_WG + (size_t)j * 64 * D * 2); map = 0; col0 = NSA_N; cmax = NSA_SRC - 1; }
            else if (job < 32) { const int j = job - 30; W = INPF(14) + (size_t)j * D * ML_SRC; ldw = ML_SRC; K = D; N = 32; WT = (bf16*)(ws + WS_WG + (size_t)(2 * 64 + j * 32) * D * 2); map = 0; col0 = ML_N; cmax = ML_SRC - 1; }
            else { const int q = job - 32; W = INPF(12) + (size_t)q * 512 * 128; ldw = 128; K = 512; N = 128; WT = (bf16*)(ws + WS_WC2 + (size_t)q * 128 * 512 * 2); }
            const unsigned long long wq = (unsigned long long)W, tq = (unsigned long long)WT;
            jt[job * 12 + 0] = (unsigned)wq; jt[job * 12 + 1] = (unsigned)(wq >> 32); jt[job * 12 + 2] = (unsigned)tq; jt[job * 12 + 3] = (unsigned)(tq >> 32);
            jt[job * 12 + 4] = (unsigned)ldw; jt[job * 12 + 5] = (unsigned)K; jt[job * 12 + 6] = (unsigned)N; jt[job * 12 + 7] = (unsigned)map; jt[job * 12 + 8] = (unsigned)col0; jt[job * 12 + 9] = (unsigned)cmax;
        }
        __syncthreads();
#pragma nounroll
        for (int job = 0; job < 36; ++job) {
            if (!((mask >> job) & 1ull)) continue;
            unsigned d[10];
#pragma unroll
            for (int e = 0; e < 10; ++e) d[e] = __builtin_amdgcn_readfirstlane(jt[job * 12 + e]);
            const float* W = (const float*)(const GAS float*)(((unsigned long long)d[1] << 32) | d[0]); bf16* WT = (bf16*)(GAS bf16*)(((unsigned long long)d[3] << 32) | d[2]);
            const int ldw = (int)d[4], K = (int)d[5], N = (int)d[6], map = (int)d[7], col0 = (int)d[8], cmax = (int)d[9];
            if (map == 1) conv_matrix_v<1>(Fc, W, ldw, K, N, WT); else if (map == 2) conv_matrix_v<2>(Fc, W, ldw, K, N, WT); else if (map == 3) conv_matrix_v<3>(Fc, W, ldw, K, N, WT); else conv_matrix<0>(Fc, W, ldw, K, N, WT, col0, cmax);
        }
#undef INPF
}

constexpr unsigned long long jb(int i) { return 1ull << i; }
constexpr unsigned long long JOBS_G0 = jb(0) | jb(1) | jb(8) | jb(9) | jb(16) | jb(18) | jb(19) | jb(22) | jb(28) | jb(32) | jb(33) | jb(10) | jb(3) | jb(11);
constexpr unsigned long long JOBS_G1 = jb(24) | jb(26) | jb(30) | jb(2);
constexpr unsigned long long JOBS_G2 = jb(4) | jb(5) | jb(6) | jb(7) | jb(12) | jb(13) | jb(14) | jb(15) | jb(17) | jb(20) | jb(21) | jb(23) | jb(29) | jb(34) | jb(35) | jb(25) | jb(27) | jb(31);
static_assert((JOBS_G0 | JOBS_G1 | JOBS_G2) == (1ull << 36) - 1 && (JOBS_G0 & JOBS_G1) == 0 && (JOBS_G0 & JOBS_G2) == 0 && (JOBS_G1 & JOBS_G2) == 0, "every weight-copy job runs exactly once");
__global__ void __launch_bounds__(NWAVES * 64, 2) fwd_kernel(Args args, double rope_r) {
    extern __shared__ __attribute__((aligned(16))) unsigned char lds[];
    const int wave_s = __builtin_amdgcn_readfirstlane(threadIdx.x >> 6);
    { const int u = wave_s * 64 + lane_id(); if (u < 256) ((LAS unsigned*)((LAS unsigned char*)lds + LDSCTL_OFF))[u] = 0u; }
    if (wave_s == 0 && lane_id() == 0) { LAS unsigned long long* tb = (LAS unsigned long long*)((LAS unsigned char*)lds + LDSCTL_OFF + 4096);
#pragma unroll
        for (int i = 0; i < 20; ++i) tb[i] = (unsigned long long)args.in[i]; }
    __syncthreads();
    const int lo = args.ph_lo, hi = args.ph_hi;
    XcdBarrier bar; bar.bar = (unsigned*)(args.ws + WS_CTL) + CW_BAR; bar.x = 0; bar.st = nullptr; bar.w = wave_s;
    if (hi - lo > 1) bar = xcd_barrier_post((unsigned*)(args.ws + WS_CTL) + CW_BAR, (volatile LAS unsigned*)((LAS unsigned char*)lds + MISC_OFF) + 8, wave_s);
    int ph = 0;
#define RUN (ph >= lo && ph < hi)
#define SEAM do { if (ph >= lo && ph + 1 < hi) xcd_barrier(bar); ++ph; } while (0)

    if (RUN) {
        const Frame F = mkframe(lds, wave_s); WSL(ws);
        conv_jobs(F, (LAS const unsigned*)((LAS unsigned char*)lds + LDSCTL_OFF + 4096), ws, JOBS_G0, 0, F.G);
        __syncthreads();
        rope_table(F, (float*)(ws + WS_ROPE), (float*)(ws + WS_ROPE) + S * 64, rope_r);
        cbias_phase(F, INP(10), INP(11), (float*)(ws + WS_CBIAS));
        __syncthreads();
        mod_phase(F, INP(1), INP(2), INP(3), (float*)(ws + WS_MOD), 0, 2, 0, F.G);
        __syncthreads();
    }
    SEAM;

    int pend = 0, pl = 0, ps = 0;
#pragma nounroll
    for (int l = 0; l < DEPTH; ++l) {
        const int j = l >> 1;
#pragma nounroll
        for (int s = 0; s < 3; ++s) {
            if (RUN) {
                const Frame F = mkframe(lds, wave_s); WSL(ws);
                const float* MOD = (const float*)(ws + WS_MOD);
                ThinArgs ta; ta.xin = pend ? args.out : INP(0); ta.xout = args.out; ta.Y = (const bf16*)(ws + WS_Y); ta.coef = (ps == 1) ? 1.0f : 0.5f;
                ta.gate = MOD + (size_t)pl * NB * NMODC + (size_t)(3 * ps + 2) * D; ta.gpost = INP(4) + (size_t)pl * 6 * D + (size_t)(2 * ps + 1) * D;
                ta.gpre = INP(4) + (size_t)l * 6 * D + (size_t)(2 * s) * D;
                ta.shift = MOD + (size_t)l * NB * NMODC + (size_t)(3 * s) * D; ta.scale = ta.shift + D; ta.H = (bf16*)(ws + WS_H); ta.pend = pend; ta.pre = 1;
                thin_phase(F, ta);
            }
            SEAM;
            if (s != 1) {
                if (RUN) {
                    WSL(ws); const int wi = 2 * l + (s >> 1);
                    pg8::Gemm g{(const bf16*)(ws + WS_H), (const bf16*)(ws + WS_W_FFIN + (size_t)wi * W_FFIN), M, 2 * FF, D, D}; pg8::StaticOrder So; So.init(M, 2 * FF, gdim, wgi);
                    pg8::EpiSwiglu E{(bf16*)(ws + WS_HID), FF};
                    pg8::gemm_phase<pg8::EpiSwiglu, pg8::StaticOrder, true, true>((LAS unsigned char*)lds, g, So, E, wave_s);
                }
                SEAM;
            } else if ((l & 1) == 0) {
                if (RUN) {
                    WSL(ws);
                    pg8::Gemm g{(const bf16*)(ws + WS_H), (const bf16*)(ws + WS_W_NSAIN + (size_t)j * W_NSAIN), M, NSA_N, D, D}; pg8::StaticOrder So; So.init(M, NSA_N, gdim, wgi);
                    pg8::EpiNsaQkv E{(bf16*)(ws + WS_QRAW), (bf16*)(ws + WS_QROT), (bf16*)(ws + WS_KV), KV_STRIDE, (const float*)(ws + WS_ROPE), (const float*)(ws + WS_ROPE) + S * 64};
                    pg8::gemm_phase<pg8::EpiNsaQkv, pg8::StaticOrder, true, true>((LAS unsigned char*)lds, g, So, E, wave_s);
                }
                SEAM;
                if (RUN) {
                    WSL(ws);
                    const int t = (wgi >= 32) ? 1 : 0;
                    pg8::Gemm g{(const bf16*)(ws + WS_KV) + (size_t)t * KV_STRIDE, (const bf16*)(ws + WS_W_CW1 + (size_t)(j * 2 + t) * W_CW1), 4096, 512, 4096, 2048};
                    pg8::StaticOrder So; So.init(4096, 512, gdim, wgi < 64 ? (wgi & 31) : 1000000);
                    pg8::EpiBiasSilu E{(bf16*)(ws + WS_CHID) + (size_t)t * 4096 * 512, 512, (const float*)(ws + WS_CBIAS) + (size_t)(j * 2 + t) * 512};
                    pg8::gemm_phase<pg8::EpiBiasSilu, pg8::StaticOrder, true, true>((LAS unsigned char*)lds, g, So, E, wave_s);
                    __syncthreads();
                    const Frame F = mkframe(lds, wave_s);
                    if (l == 0 && F.wg >= 64) { conv_jobs(F, (LAS const unsigned*)((LAS unsigned char*)lds + LDSCTL_OFF + 4096), ws, JOBS_G1, 64, F.G - 64); __syncthreads(); }
                    thin_proj<0, 3>(F, (const bf16*)(ws + WS_H), (const bf16*)(ws + WS_WG + (size_t)j * 64 * D * 2), nullptr, (float*)(ws + WS_GATE), 48);
                }
                SEAM;
                if (RUN) { const Frame F = mkframe(lds, wave_s); WSL(ws); cmp2_mfma(F, (const bf16*)(ws + WS_CHID), (const bf16*)(ws + WS_WC2 + (size_t)j * 2 * 128 * 512 * 2), (bf16*)(ws + WS_KCVC)); }
                SEAM;
                if (RUN) { const Frame F = mkframe(lds, wave_s); WSL(ws); imp_phase_mfma(F, (char*)lds, (const bf16*)(ws + WS_QRAW), (const bf16*)(ws + WS_KCVC), (const bf16*)(ws + WS_KCVC) + 4096 * 128, (const float*)(ws + WS_GATE), (float*)(ws + WS_OACC), (unsigned*)(ws + WS_MASK)); }
                SEAM;
                if (RUN) { const Frame F = mkframe(lds, wave_s); WSL(ws);
                    att_phase_mfma(F, (char*)lds, (const bf16*)(ws + WS_QROT), (const bf16*)(ws + WS_KV), (const float*)(ws + WS_GATE), (float*)(ws + WS_OACC), (const unsigned*)(ws + WS_MASK), (bf16*)(ws + WS_O)); }
                SEAM;
            } else {
                if (RUN) {
                    WSL(ws);
                    pg8::Gemm g{(const bf16*)(ws + WS_H), (const bf16*)(ws + WS_W_MLIN + (size_t)j * W_MLIN), M, ML_N, D, D}; pg8::StaticOrder So; So.init(M, ML_N, gdim, wgi);
                    pg8::EpiBf16 E{(bf16*)(ws + WS_MLQ), ML_N};
                    pg8::gemm_phase<pg8::EpiBf16, pg8::StaticOrder, true, true>((LAS unsigned char*)lds, g, So, E, wave_s);
                    __syncthreads();
                    { const Frame F = mkframe(lds, wave_s); thin_proj<1, 1>(F, (const bf16*)(ws + WS_H), (const bf16*)(ws + WS_WG + (size_t)(2 * 64 + j * 32) * D * 2), INP(17) + (size_t)j * 16, (float*)(ws + WS_GATE), 16); }
                }
                SEAM;
                if (RUN) { const Frame F = mkframe(lds, wave_s); WSL(ws); mlstm_cell_mfma(F, (const bf16*)(ws + WS_MLQ), (const float*)(ws + WS_GATE), INP(15) + (size_t)j * 4 * 2048, INP(16) + (size_t)j * 2048, INP(18) + (size_t)j * 2048, (bf16*)(ws + WS_O));  if (l == 1 && F.wg >= 64) { __syncthreads(); conv_jobs(F, (LAS const unsigned*)((LAS unsigned char*)lds + LDSCTL_OFF + 4096), ws, JOBS_G2, 64, F.G - 64); __syncthreads(); mod_phase(F, INP(1), INP(2), INP(3), (float*)(ws + WS_MOD), 2, 2, 64, F.G - 64); } }
                SEAM;
            }
            if (RUN) {
                WSL(ws);
                const bf16* Ay; const bf16* By; int Ky;
                if (s != 1) { Ay = (const bf16*)(ws + WS_HID); By = (const bf16*)(ws + WS_W_FFOUT + (size_t)(2 * l + (s >> 1)) * W_FFOUT); Ky = FF; }
                else { Ay = (const bf16*)(ws + WS_O); By = (const bf16*)(ws + ((l & 1) ? WS_W_MLOUT : WS_W_NSAOUT) + (size_t)j * W_SQ); Ky = D; }
                pg8::Gemm g{Ay, By, M, D, Ky, Ky}; pg8::StaticOrder So; So.init(M, D, gdim, wgi);
                pg8::EpiBf16 E{(bf16*)(ws + WS_Y), D};
                pg8::gemm_phase<pg8::EpiBf16, pg8::StaticOrder, true, true>((LAS unsigned char*)lds, g, So, E, wave_s);
            }
            SEAM;
            pend = 1; pl = l; ps = s;
        }
    }
    if (RUN) {
        const Frame F = mkframe(lds, wave_s); WSL(ws);
        const float* MOD = (const float*)(ws + WS_MOD);
        ThinArgs ta; ta.xin = args.out; ta.xout = args.out; ta.Y = (const bf16*)(ws + WS_Y); ta.coef = 0.5f;
        ta.gate = MOD + (size_t)pl * NB * NMODC + (size_t)(3 * ps + 2) * D; ta.gpost = INP(4) + (size_t)pl * 6 * D + (size_t)(2 * ps + 1) * D;
        ta.gpre = nullptr; ta.shift = nullptr; ta.scale = nullptr; ta.H = nullptr; ta.pend = 1; ta.pre = 0;
        thin_phase(F, ta);
    }
    SEAM;
#undef RUN
#undef SEAM
}

constexpr int NPHASES = 1 + 2 * 13 + 2 * 10 + 1;
#ifndef N_LAUNCH_MODE
#define N_LAUNCH_MODE 1
#endif
extern "C" void kernel_launch(void* const* d_in, const int* in_sizes, int n_in, void* d_out, int out_size, void* d_ws, size_t ws_size, hipStream_t stream) {
    static int grid = 0;
    if (grid == 0) {
        if (n_in != 20 || in_sizes[0] != M * D || out_size != M * D || ws_size < WS_END) { fprintf(stderr, "kernel_launch: unexpected shapes: n_in %d in0 %d out %d ws %zu (need %zu)\n", n_in, n_in > 0 ? in_sizes[0] : -1, out_size, ws_size, (size_t)WS_END); grid = -1; return; }
        int dev = 0, cus = 0, per_cu = 0;
        if (hipGetDevice(&dev) != hipSuccess || hipDeviceGetAttribute(&cus, hipDeviceAttributeMultiprocessorCount, dev) != hipSuccess) { grid = -1; return; }
        if (hipFuncSetAttribute((const void*)fwd_kernel, hipFuncAttributeMaxDynamicSharedMemorySize, LDS_BYTES) != hipSuccess) { fprintf(stderr, "kernel_launch: hipFuncSetAttribute failed\n"); grid = -1; return; }
        if (hipOccupancyMaxActiveBlocksPerMultiprocessor(&per_cu, (const void*)fwd_kernel, NWAVES * 64, LDS_BYTES) != hipSuccess || per_cu < 1) fprintf(stderr, "kernel_launch: occupancy query says %d\n", per_cu);
        (void)hipGetLastError();
        grid = cus;
    }
    if (grid < 0) return;
    if (hipMemsetAsync((char*)d_ws + WS_CTL, 0, CTL_ZERO_BYTES, stream) != hipSuccess) return;
    Args a{};
    for (int i = 0; i < 20; ++i) a.in[i] = (const float*)d_in[i];
    a.out = (float*)d_out; a.ws = (unsigned char*)d_ws;
    const double rope_r = 0.86596432336006535;
    if (N_LAUNCH_MODE == 1) {
        a.ph_lo = 0; a.ph_hi = NPHASES;
        hipLaunchKernelGGL(fwd_kernel, dim3(grid), dim3(NWAVES * 64), LDS_BYTES, stream, a, rope_r);
    } else {
        for (int p = 0; p < NPHASES; ++p) { a.ph_lo = p; a.ph_hi = p + 1; hipLaunchKernelGGL(fwd_kernel, dim3(grid), dim3(NWAVES * 64), LDS_BYTES, stream, a, rope_r); }
    }
    const hipError_t le = hipPeekAtLastError();
    if (le != hipSuccess) fprintf(stderr, "kernel_launch: launch failed: %s\n", hipGetErrorName(le));
}
```

```cpp
#include <hip/hip_runtime.h>
#include <cstdio>
#include <cstdint>

namespace pg8 {
#define PG8_LAS __attribute__((address_space(3)))
typedef unsigned short bf16_t;
typedef short bf16x8 __attribute__((ext_vector_type(8)));
typedef float f32x4 __attribute__((ext_vector_type(4)));
typedef unsigned u32x4 __attribute__((ext_vector_type(4)));
typedef unsigned u32x2 __attribute__((ext_vector_type(2)));
constexpr int BM = 256, BK = 64, HALF = 128, HTB = HALF * BK * 2  , STAGE_BYTES = 8 * HTB, NXCD = 8, WGM = 8;

__host__ __device__ __forceinline__ int lds_byte(int r, int c) { const int st = (r >> 4) * 2 + (c >> 5), rr = r & 15, cc = c & 31, ob = rr * 64 + cc * 2; return st * 1024 + (ob ^ (((ob >> 9) & 1) << 5)); }
__host__ __device__ __forceinline__ void stage_rc(int b, int& R, int& C) { const int st = b / 1024, sb = b % 1024, swz = sb ^ (((sb >> 9) & 1) << 5); R = (st >> 1) * 16 + swz / 64; C = (st & 1) * 32 + (swz % 64) / 2; }
__host__ __device__ __forceinline__ int perm32(int rho) { const int n = rho >> 4, i = rho & 15; return 8 * (i >> 2) + 4 * n + (i & 3); }

struct Unit { int pm, pn; };
struct Gemm { const bf16_t* A; const bf16_t* Bt; int M, N, K, lda; };

struct StaticOrder {
    int nM, nN, nwg, G, c;
    __host__ __device__ void init(int M, int N, int G_, int c_) { nM = M / BM; nN = N / BM; nwg = nM * nN; G = G_; c = c_; }
    __host__ __device__ bool next(int i, Unit& u) const {
        const long L = (long)i * G + c; if (L >= nwg) return false;
        int wgid = (int)L; { const int q = nwg / NXCD, r = nwg % NXCD, xcd = wgid % NXCD, off = wgid / NXCD; wgid = (xcd < r ? xcd * (q + 1) : r * (q + 1) + (xcd - r) * q) + off; }
        const int nig = WGM * nN, gid = wgid / nig, fm = gid * WGM, gsz = (nM - fm) < WGM ? (nM - fm) : WGM;
        u.pm = fm + ((wgid % nig) % gsz); u.pn = (wgid % nig) / gsz; return true;
    }
    __device__ __forceinline__ void a_ready(const Unit&) const {}
    __device__ __forceinline__ void done(const Unit&) const {}
};

__device__ __forceinline__ unsigned cvt_pk_bf16(float lo, float hi) { unsigned r; asm volatile("v_cvt_pk_bf16_f32 %0, %1, %2" : "=v"(r) : "v"(lo), "v"(hi)); return r; }
__device__ __forceinline__ float silu_f(float g) { return g * __builtin_amdgcn_rcpf(1.0f + __expf(-g)); }

struct EpiF32 {
    static constexpr bool PERM = false, AFTER_DRAIN = false;
    float* C; int ldc;
    __device__ __forceinline__ void operator()(const f32x4 (&acc)[2][2][4][2], const Unit& u, int wr, int wc, int fr, int fq) const {
        const int row0 = u.pm * BM + wr * 64 + fr, col0 = u.pn * BM + wc * 32 + 4 * fq;
#pragma unroll
        for (int ai = 0; ai < 2; ++ai)
#pragma unroll
            for (int m = 0; m < 4; ++m) { float* rowp = C + (size_t)(row0 + ai * HALF + m * 16) * ldc + col0;
#pragma unroll
                for (int bj = 0; bj < 2; ++bj)
#pragma unroll
                    for (int n = 0; n < 2; ++n) *(f32x4*)(rowp + bj * HALF + n * 16) = acc[ai][bj][m][n]; }
    }
};
struct EpiBf16 {
    static constexpr bool PERM = true, AFTER_DRAIN = false;
    bf16_t* O; int ldc;
    __device__ __forceinline__ void operator()(const f32x4 (&acc)[2][2][4][2], const Unit& u, int wr, int wc, int fr, int fq) const {
        const int row0 = u.pm * BM + wr * 64 + fr, col0 = u.pn * BM + wc * 32 + 8 * fq;
#pragma unroll
        for (int ai = 0; ai < 2; ++ai)
#pragma unroll
            for (int m = 0; m < 4; ++m) { bf16_t* rowp = O + (size_t)(row0 + ai * HALF + m * 16) * ldc + col0;
#pragma unroll
                for (int bj = 0; bj < 2; ++bj) { const f32x4 v0 = acc[ai][bj][m][0], v1 = acc[ai][bj][m][1];
                    u32x4 w; w.x = cvt_pk_bf16(v0[0], v0[1]); w.y = cvt_pk_bf16(v0[2], v0[3]); w.z = cvt_pk_bf16(v1[0], v1[1]); w.w = cvt_pk_bf16(v1[2], v1[3]);
                    *(u32x4*)(rowp + bj * HALF) = w; } }
    }
};
struct EpiBiasSilu {
    static constexpr bool PERM = true, AFTER_DRAIN = false;
    bf16_t* O; int ldc; const float* bias;
    __device__ __forceinline__ void operator()(const f32x4 (&acc)[2][2][4][2], const Unit& u, int wr, int wc, int fr, int fq) const {
        const int row0 = u.pm * BM + wr * 64 + fr, col0 = u.pn * BM + wc * 32 + 8 * fq;
        f32x4 bv[2][2];
#pragma unroll
        for (int bj = 0; bj < 2; ++bj)
#pragma unroll
            for (int n = 0; n < 2; ++n) bv[bj][n] = *(const f32x4*)(bias + col0 + bj * HALF + 4 * n);
#pragma unroll
        for (int ai = 0; ai < 2; ++ai)
#pragma unroll
            for (int m = 0; m < 4; ++m) { bf16_t* rowp = O + (size_t)(row0 + ai * HALF + m * 16) * ldc + col0;
#pragma unroll
                for (int bj = 0; bj < 2; ++bj) { f32x4 v0 = acc[ai][bj][m][0] + bv[bj][0], v1 = acc[ai][bj][m][1] + bv[bj][1];
#pragma unroll
                    for (int j = 0; j < 4; ++j) { v0[j] = silu_f(v0[j]); v1[j] = silu_f(v1[j]); }
                    u32x4 w; w.x = cvt_pk_bf16(v0[0], v0[1]); w.y = cvt_pk_bf16(v0[2], v0[3]); w.z = cvt_pk_bf16(v1[0], v1[1]); w.w = cvt_pk_bf16(v1[2], v1[3]);
                    *(u32x4*)(rowp + bj * HALF) = w; } }
    }
};
struct EpiSwiglu {
    static constexpr bool PERM = true, AFTER_DRAIN = false;
    bf16_t* O; int ldc;
    __device__ __forceinline__ void operator()(const f32x4 (&acc)[2][2][4][2], const Unit& u, int wr, int wc, int fr, int fq) const {
        const int row0 = u.pm * BM + wr * 64 + fr, col0 = u.pn * HALF + wc * 32 + 8 * fq;
#pragma unroll
        for (int ai = 0; ai < 2; ++ai)
#pragma unroll
            for (int m = 0; m < 4; ++m) { bf16_t* rowp = O + (size_t)(row0 + ai * HALF + m * 16) * ldc + col0;
                f32x4 h0, h1;
#pragma unroll
                for (int j = 0; j < 4; ++j) { h0[j] = silu_f(acc[ai][0][m][0][j]) * acc[ai][1][m][0][j]; h1[j] = silu_f(acc[ai][0][m][1][j]) * acc[ai][1][m][1][j]; }
                u32x4 w; w.x = cvt_pk_bf16(h0[0], h0[1]); w.y = cvt_pk_bf16(h0[2], h0[3]); w.z = cvt_pk_bf16(h1[0], h1[1]); w.w = cvt_pk_bf16(h1[2], h1[3]);
                *(u32x4*)rowp = w; }
    }
};
struct EpiNsaQkv {
    static constexpr bool PERM = true, AFTER_DRAIN = false;
    bf16_t* qraw; bf16_t* qrot; bf16_t* kv;
    size_t kvstride; const float* cs; const float* sn;
    __device__ __forceinline__ void operator()(const f32x4 (&acc)[2][2][4][2], const Unit& u, int wr, int wc, int fr, int fq) const {
        const int d0 = wc * 16 + 4 * fq;
#pragma unroll
        for (int bj = 0; bj < 2; ++bj) {
            const int hb = 2 * u.pn + bj;
            const bool isq = hb < 16; const int t = (hb - 16) >> 2, g = (hb - 16) & 3; const bool rope = isq || t == 2 || t == 4;
#pragma unroll
            for (int ai = 0; ai < 2; ++ai)
#pragma unroll
                for (int m = 0; m < 4; ++m) {
                    const int row = u.pm * BM + ai * HALF + wr * 64 + m * 16 + fr, b = row >> 11, s = row & 2047;
                    const f32x4 v0 = acc[ai][bj][m][0], v1 = acc[ai][bj][m][1];
                    f32x4 r0 = v0, r1 = v1;
                    if (rope) { const f32x4 c = *(const f32x4*)(cs + s * 64 + d0), sv = *(const f32x4*)(sn + s * 64 + d0); r0 = v0 * c - v1 * sv; r1 = v1 * c + v0 * sv; }
                    u32x2 w0, w1; w0.x = cvt_pk_bf16(r0[0], r0[1]); w0.y = cvt_pk_bf16(r0[2], r0[3]); w1.x = cvt_pk_bf16(r1[0], r1[1]); w1.y = cvt_pk_bf16(r1[2], r1[3]);
                    if (isq) {
                        u32x2 p0, p1; p0.x = cvt_pk_bf16(v0[0], v0[1]); p0.y = cvt_pk_bf16(v0[2], v0[3]); p1.x = cvt_pk_bf16(v1[0], v1[1]); p1.y = cvt_pk_bf16(v1[2], v1[3]);
                        bf16_t* pr = qraw + (size_t)row * 2048 + hb * 128 + d0; *(u32x2*)pr = p0; *(u32x2*)(pr + 64) = p1;
                        bf16_t* po = qrot + ((size_t)((b * 16 + hb) * 2048 + s)) * 128 + d0; *(u32x2*)po = w0; *(u32x2*)(po + 64) = w1;
                    } else {
                        bf16_t* pk = kv + (size_t)t * kvstride + ((size_t)((b * 4 + g) * 2048 + s)) * 128 + d0; *(u32x2*)pk = w0; *(u32x2*)(pk + 64) = w1;
                    }
                }
        }
    }
};

template <class Epi, class Sched, bool ALIGN_EPI = false, bool SP2 = false>
__device__ __forceinline__ void gemm_phase(PG8_LAS unsigned char* lds, const Gemm g, const Sched& S, const Epi& E, int wave_s) {
    int ws_l = wave_s; asm volatile("" : "+s"(ws_l)); int lane_l; asm volatile("v_mbcnt_lo_u32_b32 %0, -1, 0\n\tv_mbcnt_hi_u32_b32 %0, -1, %0" : "=v"(lane_l)); const int tid_l = ws_l * 64 + lane_l;
    const int tid = tid_l, wid = __builtin_amdgcn_readfirstlane(tid >> 6), lane = tid & 63, wr = wid >> 2, wc = wid & 3, fr = lane & 15, fq = lane >> 4;
    const int K = g.K, nt = K / BK;
    unsigned voffA[2], voffB[2];
#pragma unroll
    for (int i = 0; i < 2; ++i) { int R, C; stage_rc(tid * 16 + i * 8192, R, C); const int Rb = Epi::PERM ? ((R & ~31) + perm32(R & 31)) : R;
        voffA[i] = (unsigned)(R * g.lda + C) * 2u; voffB[i] = (unsigned)(Rb * K + C) * 2u; }
    const size_t kstep = (size_t)(BK * 2);
    const size_t hstepA = (size_t)HALF * g.lda * 2, hstepB = (size_t)HALF * K * 2;
    const size_t tstepA = 2 * hstepA, tstepB = 2 * hstepB;
    const unsigned ldsw = (unsigned)wid * 1024u;
    const int aoff = lds_byte(wr * 64 + fr, fq * 8), boff = lds_byte(wc * 32 + fr, fq * 8);
#define PG8_SA(b, h) (((b) * 2 + (h)) * HTB)
#define PG8_SB(b, h) ((4 + (b) * 2 + (h)) * HTB)
#define PG8_STAGE(bufoff, gbase, voff) do { _Pragma("unroll") for (int _i = 0; _i < 2; ++_i) \
        __builtin_amdgcn_global_load_lds((const unsigned*)((const char*)(gbase) + (voff)[_i]), (PG8_LAS unsigned*)(lds + (bufoff) + ldsw + _i * 8192), 16, 0, 0); } while (0)
#define PG8_LDA(dst, b, h) do { _Pragma("unroll") for (int m = 0; m < 4; ++m) _Pragma("unroll") for (int k = 0; k < 2; ++k) dst[m][k] = *(const PG8_LAS bf16x8*)(lds + PG8_SA(b, h) + aoff + m * 2048 + k * 1024); } while (0)
#define PG8_LDB(dst, b, h) do { _Pragma("unroll") for (int n = 0; n < 2; ++n) _Pragma("unroll") for (int k = 0; k < 2; ++k) dst[n][k] = *(const PG8_LAS bf16x8*)(lds + PG8_SB(b, h) + boff + n * 2048 + k * 1024); } while (0)
#define PG8_MMA(ai, bj, At, Bt) do { __builtin_amdgcn_s_setprio(1); _Pragma("unroll") for (int m = 0; m < 4; ++m) _Pragma("unroll") for (int n = 0; n < 2; ++n) _Pragma("unroll") for (int k = 0; k < 2; ++k) \
        acc[ai][bj][m][n] = __builtin_amdgcn_mfma_f32_16x16x32_bf16(Bt[n][k], At[m][k], acc[ai][bj][m][n], 0, 0, 0); __builtin_amdgcn_s_setprio(0); } while (0)
#define PG8_WAIT_V(n) asm volatile("s_waitcnt vmcnt(" #n ")" ::: "memory")
#define PG8_WAIT_L(n) asm volatile("s_waitcnt lgkmcnt(" #n ")" ::: "memory")
#define PG8_BAR __builtin_amdgcn_s_barrier()
#define PG8_SCHED __builtin_amdgcn_sched_barrier(0)
    Unit cur, nxt; int ui = 0;
    if (!S.next(0, cur)) return;
    f32x4 acc[2][2][4][2];
#pragma unroll
    for (int a = 0; a < 2; ++a)
#pragma unroll
        for (int b = 0; b < 2; ++b)
#pragma unroll
            for (int m = 0; m < 4; ++m)
#pragma unroll
                for (int n = 0; n < 2; ++n) acc[a][b][m][n] = (f32x4){0.f, 0.f, 0.f, 0.f};
    bf16x8 At[4][2], B0[2][2], B1[2][2];
    const char* cA = (const char*)g.A + (size_t)cur.pm * tstepA; const char* cB = (const char*)g.Bt + (size_t)cur.pn * tstepB;
    S.a_ready(cur);
    if constexpr (SP2) {
        PG8_STAGE(PG8_SB(0, 0), cB, voffB); PG8_STAGE(PG8_SB(0, 1), cB + hstepB, voffB); PG8_STAGE(PG8_SA(0, 0), cA, voffA); PG8_STAGE(PG8_SA(0, 1), cA + hstepA, voffA);
        if (wr == 1) PG8_BAR;
        PG8_WAIT_V(2); PG8_BAR;
        PG8_STAGE(PG8_SB(1, 0), cB + kstep, voffB); PG8_STAGE(PG8_SA(1, 0), cA + kstep, voffA); PG8_STAGE(PG8_SB(1, 1), cB + hstepB + kstep, voffB);
        PG8_WAIT_V(6); PG8_BAR;
    } else {
        PG8_STAGE(PG8_SB(0, 0), cB, voffB); PG8_STAGE(PG8_SA(0, 0), cA, voffA); PG8_STAGE(PG8_SB(0, 1), cB + hstepB, voffB); PG8_STAGE(PG8_SA(0, 1), cA + hstepA, voffA);
        if (wr == 1) PG8_BAR;
        PG8_WAIT_V(4); PG8_BAR;
        PG8_STAGE(PG8_SB(1, 0), cB + kstep, voffB); PG8_STAGE(PG8_SA(1, 0), cA + kstep, voffA); PG8_STAGE(PG8_SB(1, 1), cB + hstepB + kstep, voffB);
        PG8_WAIT_V(6); PG8_BAR;
    }
    for (;;) {
        const bool has_next = S.next(ui + 1, nxt);
        const char* nA = has_next ? (const char*)g.A + (size_t)nxt.pm * tstepA : cA; const char* nB = has_next ? (const char*)g.Bt + (size_t)nxt.pn * tstepB : cB;
        for (int t = 0; t < nt; t += 2) {
            const bool last = (t == nt - 2);
            const char* a1 = cA + (size_t)(t + 1) * kstep;
            const char* a2 = last ? nA : cA + (size_t)(t + 2) * kstep; const char* b2 = last ? nB : cB + (size_t)(t + 2) * kstep;
            const char* a3 = a2 + kstep; const char* b3 = b2 + kstep;
            if (last && has_next) S.a_ready(nxt);
            if constexpr (SP2) {
            PG8_LDB(B0, 0, 0); PG8_LDB(B1, 0, 1); PG8_SCHED; PG8_LDA(At, 0, 0); PG8_STAGE(PG8_SA(1, 1), a1 + hstepA, voffA);
            PG8_WAIT_V(8); PG8_WAIT_L(0); PG8_BAR; PG8_MMA(0, 0, At, B0); PG8_MMA(0, 1, At, B1); PG8_BAR; PG8_SCHED;
            PG8_LDA(At, 0, 1); PG8_STAGE(PG8_SB(0, 0), b2, voffB); PG8_STAGE(PG8_SB(0, 1), b2 + hstepB, voffB); PG8_STAGE(PG8_SA(0, 0), a2, voffA);
            PG8_WAIT_V(8); PG8_WAIT_L(0); PG8_BAR; PG8_MMA(1, 0, At, B0); PG8_MMA(1, 1, At, B1); PG8_BAR; PG8_SCHED;
            PG8_LDB(B0, 1, 0); PG8_LDB(B1, 1, 1); PG8_SCHED; PG8_LDA(At, 1, 0); PG8_STAGE(PG8_SA(0, 1), a2 + hstepA, voffA);
            PG8_WAIT_V(8); PG8_WAIT_L(0); PG8_BAR; PG8_MMA(0, 0, At, B0); PG8_MMA(0, 1, At, B1); PG8_BAR; PG8_SCHED;
            PG8_LDA(At, 1, 1); PG8_STAGE(PG8_SB(1, 0), b3, voffB); PG8_STAGE(PG8_SB(1, 1), b3 + hstepB, voffB); PG8_STAGE(PG8_SA(1, 0), a3, voffA);
            PG8_WAIT_V(8); PG8_WAIT_L(0); PG8_BAR; PG8_MMA(1, 0, At, B0); PG8_MMA(1, 1, At, B1); PG8_BAR; PG8_SCHED;
            } else {
            PG8_LDB(B0, 0, 0); PG8_SCHED; PG8_LDA(At, 0, 0); PG8_STAGE(PG8_SA(1, 1), a1 + hstepA, voffA);
            PG8_WAIT_L(8); PG8_BAR; PG8_WAIT_L(0); PG8_MMA(0, 0, At, B0); PG8_BAR; PG8_SCHED;
            PG8_LDB(B1, 0, 1); PG8_STAGE(PG8_SB(0, 0), b2, voffB);
            PG8_BAR; PG8_WAIT_L(0); PG8_MMA(0, 1, At, B1); PG8_BAR;
            PG8_LDA(At, 0, 1); PG8_STAGE(PG8_SA(0, 0), a2, voffA);
            PG8_BAR; PG8_WAIT_L(0); PG8_MMA(1, 0, At, B0); PG8_BAR; PG8_SCHED;
            PG8_STAGE(PG8_SB(0, 1), b2 + hstepB, voffB);
            PG8_WAIT_V(6); PG8_BAR; PG8_MMA(1, 1, At, B1); PG8_BAR;
            PG8_LDB(B0, 1, 0); PG8_SCHED; PG8_LDA(At, 1, 0); PG8_STAGE(PG8_SA(0, 1), a2 + hstepA, voffA);
            PG8_WAIT_L(8); PG8_BAR; PG8_WAIT_L(0); PG8_MMA(0, 0, At, B0); PG8_BAR; PG8_SCHED;
            PG8_LDB(B1, 1, 1); PG8_STAGE(PG8_SB(1, 0), b3, voffB);
            PG8_BAR; PG8_WAIT_L(0); PG8_MMA(0, 1, At, B1); PG8_BAR;
            PG8_LDA(At, 1, 1); PG8_STAGE(PG8_SA(1, 0), a3, voffA);
            PG8_BAR; PG8_WAIT_L(0); PG8_MMA(1, 0, At, B0); PG8_BAR; PG8_SCHED;
            PG8_STAGE(PG8_SB(1, 1), b3 + hstepB, voffB);
            PG8_WAIT_V(6); PG8_BAR; PG8_MMA(1, 1, At, B1); PG8_BAR;
            }
        }
        if constexpr (ALIGN_EPI) { if (wr == 0) PG8_BAR; }
        if constexpr (!Epi::AFTER_DRAIN) { E(acc, cur, wr, wc, fr, fq); S.done(cur); }
        if (!has_next) break;
#pragma unroll
        for (int a = 0; a < 2; ++a)
#pragma unroll
            for (int b = 0; b < 2; ++b)
#pragma unroll
                for (int m = 0; m < 4; ++m)
#pragma unroll
                    for (int n = 0; n < 2; ++n) acc[a][b][m][n] = (f32x4){0.f, 0.f, 0.f, 0.f};
        cur = nxt; cA = nA; cB = nB; ++ui;
        if constexpr (ALIGN_EPI) { if (wr == 1) PG8_BAR; }
    }
    PG8_WAIT_V(0);
    if constexpr (!ALIGN_EPI) { if (wr == 0) PG8_BAR; }
    PG8_BAR;
    if constexpr (Epi::AFTER_DRAIN) { E.fused(acc, cur, wr, wc, fr, fq, lds, wid, lane); S.done(cur); }
#undef PG8_SA
#undef PG8_SB
#undef PG8_STAGE
#undef PG8_LDA
#undef PG8_LDB
#undef PG8_MMA
#undef PG8_WAIT_V
#undef PG8_WAIT_L
#undef PG8_BAR
#undef PG8_SCHED
}
}

namespace att {
typedef unsigned short bf16;
typedef short bf16x8 __attribute__((ext_vector_type(8)));
typedef short s16x4 __attribute__((ext_vector_type(4)));
typedef float f32x16 __attribute__((ext_vector_type(16)));
typedef float f32x4 __attribute__((ext_vector_type(4)));
typedef unsigned u32x4 __attribute__((ext_vector_type(4)));
constexpr int D = 128, NW = 8, QBLK = 32, KVBLK = 64, QB = NW * QBLK, SKV = 2048;
constexpr float SCALE = 0.08838834764831845f, THR = 8.f;
constexpr int SHM_V = KVBLK * D * 2, SHM_K = KVBLK * D * 2;
constexpr int LDS_BYTES = 2 * SHM_V + 2 * SHM_K + NW * 64 * 4;

#define KSWZ(row, colB) ((row) * 256 + ((colB) ^ (((row) & 7) << 4)))
#define SBAR() __builtin_amdgcn_sched_barrier(0)
__device__ __forceinline__ int v_st(int k, int c) { const int kk = (k & ~0xC) | ((k & 4) << 1) | ((k & 8) >> 1); return ((kk >> 3) * 4 + (c >> 5)) * 512 + ((kk & 7) * 32 + (c & 31)) * 2; }
__device__ __forceinline__ int v_rd_base(int lane) { return ((lane & 3) << 3) | (((lane >> 2) & 3) << 6) | (((lane >> 4) & 1) << 5) | (((lane >> 5) & 1) << 8); }
constexpr int v_rd_off(int d0, int ks, int half) { return d0 * 512 + ks * 4096 + half * 2048; }
__device__ __forceinline__ int crow(int r, int hi) { return (r & 3) + 8 * (r >> 2) + 4 * hi; }
__device__ __forceinline__ unsigned cvtpk(float lo, float hi) { unsigned r; asm volatile("v_cvt_pk_bf16_f32 %0, %1, %2" : "=v"(r) : "v"(lo), "v"(hi)); return r; }
__device__ __forceinline__ void swap32(unsigned& a, unsigned& b) { asm volatile("s_nop 1\n\tv_permlane32_swap_b32 %0, %1\n\ts_nop 1" : "+v"(a), "+v"(b)); }
__device__ __forceinline__ bf16x8 load8(const bf16* p) { return *reinterpret_cast<const bf16x8*>(p); }
__device__ __forceinline__ void mask_tile(f32x16& p0, f32x16& p1, int dq, unsigned W) {
    const float NEG = -__builtin_inff();
#pragma unroll
    for (int r = 0; r < 16; ++r) {
        const int c = (r & 3) + 8 * (r >> 2);
        if ((unsigned)(dq - c) >= W) p0[r] = NEG;
        if ((unsigned)(dq - c - 32) >= W) p1[r] = NEG;
    }
}
__device__ __forceinline__ void selmask_tile(f32x16& p0, f32x16& p1, bool on) {
    const float NEG = -__builtin_inff();
#pragma unroll
    for (int r = 0; r < 16; ++r) { p0[r] = on ? p0[r] : NEG; p1[r] = on ? p1[r] : NEG; }
}
__device__ __forceinline__ void partialSM(f32x16& p0, f32x16& p1, float& m_reg, float& mn, float& alpha) {
    float pmax = p0[0]; for (int r = 1; r < 16; ++r) pmax = fmaxf(pmax, p0[r]); for (int r = 0; r < 16; ++r) pmax = fmaxf(pmax, p1[r]);
    { unsigned pa_ = __float_as_uint(pmax), pb_ = pa_; swap32(pa_, pb_); pmax = fmaxf(__uint_as_float(pa_), __uint_as_float(pb_)); }
    constexpr float C2 = 1.4426950408889634f * SCALE;
    if (__builtin_expect(__all((pmax - m_reg) * SCALE <= THR), 1)) { mn = m_reg; alpha = 1.f; }
    else { mn = fmaxf(m_reg, pmax); alpha = __builtin_amdgcn_exp2f((m_reg - mn) * C2); m_reg = mn; }
    const float mnL = -mn * C2;
    for (int r = 0; r < 16; ++r) p0[r] = fmaf(p0[r], C2, mnL); for (int r = 0; r < 16; ++r) p1[r] = fmaf(p1[r], C2, mnL);
    for (int r = 0; r < 16; ++r) p0[r] = __builtin_amdgcn_exp2f(p0[r]);
}
__device__ __forceinline__ void finishSM(f32x16& p0, f32x16& p1, float alpha, float& l_reg, bf16x8& pa0, bf16x8& pa1, bf16x8& pa2, bf16x8& pa3) {
    for (int r = 0; r < 16; ++r) p1[r] = __builtin_amdgcn_exp2f(p1[r]);
    float ps = 0; for (int r = 0; r < 16; ++r) ps += p0[r]; for (int r = 0; r < 16; ++r) ps += p1[r];
    { unsigned pa_ = __float_as_uint(ps), pb_ = pa_; swap32(pa_, pb_); ps = __uint_as_float(pa_) + __uint_as_float(pb_); }
    l_reg = l_reg * alpha + ps;
#define PK4(P, B_, OUT) do { unsigned a0 = cvtpk(P[B_+0], P[B_+1]), a1 = cvtpk(P[B_+2], P[B_+3]);                          \
        unsigned b0 = cvtpk(P[B_+4], P[B_+5]), b1 = cvtpk(P[B_+6], P[B_+7]);                                             \
        swap32(a0, b0); swap32(a1, b1); \
        u32x4 w = {a0, a1, b0, b1}; OUT = *reinterpret_cast<bf16x8*>(&w); } while (0)
    PK4(p0, 0, pa0); PK4(p0, 8, pa1); PK4(p1, 0, pa2); PK4(p1, 8, pa3);
#undef PK4
}
template <int KB, bool SK>
__device__ __forceinline__ void qkt(f32x16& p0, f32x16& p1, const char* K_lds, int r32, int hi, const bf16x8* qr, bool act) {
    if (SK && !act) { const float NEG = -__builtin_inff();
#pragma unroll
        for (int r = 0; r < 16; ++r) { p0[r] = NEG; p1[r] = NEG; } return; }
    p0 = f32x16{}; p1 = f32x16{};
    const char* kb[4];
#pragma unroll
    for (int dd = 0; dd < 4; ++dd) kb[dd] = K_lds + KB * SHM_K + KSWZ(r32, (dd * 16 + hi * 8) * 2);
#pragma unroll
    for (int d0 = 0; d0 < 8; ++d0) { const char* a = kb[d0 & 3] + (d0 >> 2) * 128;
        bf16x8 b0 = *reinterpret_cast<const bf16x8*>(a);
        bf16x8 b1 = *reinterpret_cast<const bf16x8*>(a + 32 * 256);
        p0 = __builtin_amdgcn_mfma_f32_32x32x16_bf16(b0, qr[d0], p0, 0, 0, 0);
        p1 = __builtin_amdgcn_mfma_f32_32x32x16_bf16(b1, qr[d0], p1, 0, 0, 0); }
}
template <int VB, bool SK>
__device__ __forceinline__ void pv_tile(f32x16* o, int vb0, bf16x8 pa0, bf16x8 pa1, bf16x8 pa2, bf16x8 pa3, bool act) {
    if (SK && !act) return;
#define TRRD(dst, off) asm volatile("ds_read_b64_tr_b16 %0, %1 offset:%2" : "=&v"(dst) : "v"(vb0), "i"(off) : "memory")
#define PV_D0(d0) do { s16x4 l0, l1, l2, l3, h0, h1, h2, h3; constexpr int b_ = VB * SHM_V + v_rd_off(d0, 0, 0); \
        TRRD(l0, b_); TRRD(h0, b_ + 2048); TRRD(l1, b_ + 4096); TRRD(h1, b_ + 6144); TRRD(l2, b_ + 8192); TRRD(h2, b_ + 10240); TRRD(l3, b_ + 12288); TRRD(h3, b_ + 14336); \
        asm volatile("s_waitcnt lgkmcnt(0)" ::: "memory"); SBAR();   \
        o[d0] = __builtin_amdgcn_mfma_f32_32x32x16_bf16(pa0, (bf16x8){l0[0], l0[1], l0[2], l0[3], h0[0], h0[1], h0[2], h0[3]}, o[d0], 0, 0, 0);   \
        o[d0] = __builtin_amdgcn_mfma_f32_32x32x16_bf16(pa1, (bf16x8){l1[0], l1[1], l1[2], l1[3], h1[0], h1[1], h1[2], h1[3]}, o[d0], 0, 0, 0);   \
        o[d0] = __builtin_amdgcn_mfma_f32_32x32x16_bf16(pa2, (bf16x8){l2[0], l2[1], l2[2], l2[3], h2[0], h2[1], h2[2], h2[3]}, o[d0], 0, 0, 0);   \
        o[d0] = __builtin_amdgcn_mfma_f32_32x32x16_bf16(pa3, (bf16x8){l3[0], l3[1], l3[2], l3[3], h3[0], h3[1], h3[2], h3[3]}, o[d0], 0, 0, 0); } while (0)
    PV_D0(0); PV_D0(1); PV_D0(2); PV_D0(3);
#undef PV_D0
#undef TRRD
}

struct BlockRef { const bf16* Q; const bf16* K; const bf16* V; int P0, row0; };
struct Seam { bf16x8 qr[8]; bf16x8 st_v0, st_v1, st_k0, st_k1; };
__device__ __forceinline__ int swa_jlo(int P0, int W) { const int lowk = P0 - W + 1; return lowk > 0 ? lowk / KVBLK : 0; }
#define VMW() asm volatile("s_waitcnt vmcnt(0)" ::: "memory")
#define VMWN(n) asm volatile("s_waitcnt vmcnt(%0)" :: "i"(n) : "memory")
#define LDG16(base, off) (*reinterpret_cast<const bf16x8*>((const char*)(base) + (off)))
#define SLOAD_H(Kp, Vp, k0) do { const char* kb_ = (const char*)(Kp) + (size_t)(k0) * (D * 2); const char* vb_ = (const char*)(Vp) + (size_t)(k0) * (D * 2);   \
                         S.st_v0 = LDG16(vb_, toff); S.st_v1 = LDG16(vb_ + 32 * D * 2, toff); S.st_k0 = LDG16(kb_, toff); S.st_k1 = LDG16(kb_ + 32 * D * 2, toff); } while (0)
#define SWRITE_HK(bf) do { *(bf16x8*)(K_lds + (bf) * SHM_K + kws) = S.st_k0; *(bf16x8*)(K_lds + (bf) * SHM_K + kws + 32 * 256) = S.st_k1; } while (0)
#define SWRITE_HV(bf) do { *(bf16x8*)(V_lds + (bf) * SHM_V + vst0) = S.st_v0; *(bf16x8*)(V_lds + (bf) * SHM_V + vst1) = S.st_v1; } while (0)
#define SWRITE_H(bf) do { SWRITE_HV(bf); SWRITE_HK(bf); } while (0)
__device__ __forceinline__ void att_prime(const BlockRef& cur, int W, char* lds, Seam& S, int tid) {
    asm volatile("" : "+v"(tid));
    const int wid = __builtin_amdgcn_readfirstlane(tid >> 6), lane = tid & 63, r32 = lane & 31, hi = lane >> 5;
    const int sr = tid >> 4, sc = (tid & 15) * 8, kws = KSWZ(sr, sc * 2); char* K_lds = lds + 2 * SHM_V;
    const unsigned toff = (unsigned)(sr * D + sc) * 2u, qoffb = (unsigned)((wid * QBLK + r32) * D + hi * 8) * 2u;
    const int kb0 = swa_jlo(cur.P0, W) * KVBLK;
    for (int d0 = 0; d0 < 8; ++d0) S.qr[d0] = LDG16((const char*)cur.Q + d0 * 32, qoffb);
    SLOAD_H(cur.K, cur.V, kb0); VMW(); SWRITE_HK(0);
    __syncthreads();
}
template <int MODE>
__device__ __forceinline__ void att_block(const BlockRef& cur, const BlockRef& nxt, int Wn, char* lds, Seam& S, int tid,
                                          int head, const float* gate, float* oacc, bf16* obf, const unsigned* msk  ) {
    constexpr bool SK = (MODE == 1);
    constexpr int W = (MODE == 1) ? 512 : (1 << 24);
    asm volatile("" : "+v"(tid));
    const int wid = __builtin_amdgcn_readfirstlane(tid >> 6), lane = tid & 63, r32 = lane & 31, hi = lane >> 5;
    const int j_lo = swa_jlo(cur.P0, W);
    int j_hi = (cur.P0 + QB - 1) / KVBLK + 1; if (j_hi > SKV / KVBLK) j_hi = SKV / KVBLK;
    const int NT = j_hi - j_lo;
    const int kbn = swa_jlo(nxt.P0, Wn) * KVBLK;
    const int qlo = cur.P0 + wid * QBLK, qm = qlo + r32 - 4 * hi;
    unsigned selbits = 0xffffffffu; if (MODE == 0) selbits = msk[qlo + r32];
    char* V_lds = lds; char* K_lds = lds + 2 * SHM_V;
    float* ws = (float*)(lds + 2 * SHM_V + 2 * SHM_K) + wid * 64; float* li_l = ws, * al_l = ws + 32;
    float m_reg = -1e30f, l_reg = 0; f32x16 o[4] = {};
    const int sr = tid >> 4, sc = (tid & 15) * 8, vst0 = v_st(sr, sc), vst1 = v_st(32 + sr, sc), kws = KSWZ(sr, sc * 2);
    const unsigned toff = (unsigned)(sr * D + sc) * 2u, qoffb = (unsigned)((wid * QBLK + r32) * D + hi * 8) * 2u;
    const int vb0 = (int)(uintptr_t)V_lds + v_rd_base(lane);
    const bf16* Kh = cur.K; const bf16* Vh = cur.V;
#define RESC(a) do { if (__any((a) < 1.f)) { if (hi == 0) al_l[r32] = (a); asm volatile("s_waitcnt lgkmcnt(0)" ::: "memory");              \
                     for (int d_ = 0; d_ < 4; ++d_) for (int r = 0; r < 16; ++r) o[d_][r] *= al_l[crow(r, hi)]; } } while (0)
#define KBASE(t) ((j_lo + (t)) * KVBLK)
#define ACT(t) (KBASE(t) <= qlo + QBLK - 1 && KBASE(t) + KVBLK - 1 >= qlo - W + 1)
#define MASKT(P0_, P1_, t) do { const int kb_ = KBASE(t); if ((!SK || ACT(t)) && (kb_ + KVBLK - 1 > qlo || kb_ <= qlo + QBLK - 1 - W)) mask_tile(P0_, P1_, qm - kb_, (unsigned)W); \
        if (MODE == 0) selmask_tile(P0_, P1_, ((selbits >> (j_lo + (t))) & 1u) != 0u); } while (0)
    constexpr int NQL = 8;
#define SEAM_K0() do { VMWN(NQL); SWRITE_HK(0); SBAR(); } while (0)
    f32x16 pA0, pA1, pB0, pB1; float mnA, mnB, alA, alB; bf16x8 pa0, pa1, pa2, pa3;
    SWRITE_HV(0); SBAR();
    if (NT > 1) { SLOAD_H(Kh, Vh, KBASE(1)); }
    SBAR(); qkt<0, SK>(pA0, pA1, K_lds, r32, hi, S.qr, ACT(0));
    MASKT(pA0, pA1, 0); partialSM(pA0, pA1, m_reg, mnA, alA);
    if (NT > 1) { VMW(); SWRITE_H(1); }
    __syncthreads();
#define HALF_STEP(PX0, PX1, mnX, alX, PY0, PY1, alY, t, KB, VB, SB) do {                                                      \
        SBAR(); qkt<KB, SK>(PX0, PX1, K_lds, r32, hi, S.qr, ACT(t));                                             \
        finishSM(PY0, PY1, alY, l_reg, pa0, pa1, pa2, pa3); SBAR();                                                           \
        if ((t) + 1 < NT) { SLOAD_H(Kh, Vh, KBASE((t) + 1)); SBAR(); }                                               \
        pv_tile<VB, SK>(o, vb0, pa0, pa1, pa2, pa3, ACT((t) - 1)); MASKT(PX0, PX1, (t)); partialSM(PX0, PX1, m_reg, mnX, alX);                                        \
        __syncthreads();                                                                                                      \
        if ((t) + 1 < NT) { VMW(); SWRITE_H(SB); }                                                                          \
        RESC(alX); __syncthreads(); } while (0)
    for (int t = 1; t + 1 < NT; t += 2) {
        HALF_STEP(pB0, pB1, mnB, alB, pA0, pA1, alA, t, 1, 0, 0);
        HALF_STEP(pA0, pA1, mnA, alA, pB0, pB1, alB, t + 1, 0, 1, 1);
    }
    const bool even = (NT & 1) == 0;
    if (even) { SBAR(); qkt<1, SK>(pB0, pB1, K_lds, r32, hi, S.qr, ACT(NT - 1)); SBAR(); }
    SLOAD_H(nxt.K, nxt.V, kbn); SBAR();
#pragma unroll
    for (int d0 = 0; d0 < 8; ++d0) S.qr[d0] = LDG16((const char*)nxt.Q + d0 * 32, qoffb);
    SBAR();
    finishSM(pA0, pA1, alA, l_reg, pa0, pa1, pa2, pa3); SBAR();
    pv_tile<0, SK>(o, vb0, pa0, pa1, pa2, pa3, ACT(even ? NT - 2 : NT - 1));
    if (even) { MASKT(pB0, pB1, NT - 1); partialSM(pB0, pB1, m_reg, mnB, alB); __syncthreads(); RESC(alB);
        finishSM(pB0, pB1, alB, l_reg, pa0, pa1, pa2, pa3); SBAR(); pv_tile<1, SK>(o, vb0, pa0, pa1, pa2, pa3, ACT(NT - 1)); }
    SBAR(); SEAM_K0();
    if (hi == 0) li_l[r32] = l_reg; asm volatile("s_waitcnt lgkmcnt(0)" ::: "memory");
    float rli[16];
    const unsigned rowt = (unsigned)(cur.row0 + wid * QBLK + 4 * hi);
#pragma unroll
    for (int r = 0; r < 16; ++r) { const unsigned gro = (rowt + (unsigned)((r & 3) + 8 * (r >> 2))) * 192u + (unsigned)(head * 12 + 4 + 4 * MODE);
        rli[r] = __builtin_amdgcn_rcpf(li_l[crow(r, hi)]) * *(const float*)((const char*)gate + gro); }
#pragma unroll
    for (int r = 0; r < 16; ++r) { const unsigned ro = ((rowt + (unsigned)((r & 3) + 8 * (r >> 2))) * 2048u + (unsigned)(head * 128 + r32)) * 4u;
#pragma unroll
        for (int d0 = 0; d0 < 4; ++d0) { const float v = o[d0][r] * rli[r]; float* pa = (float*)((char*)oacc + ro + d0 * 128);
            if (MODE == 0) { *pa += v; }
            else { const float tot = *pa + v; const float vn = __builtin_bit_cast(float, __builtin_amdgcn_ds_swizzle(__builtin_bit_cast(int, tot), (1 << 10) | 0x1f));
                   if ((r32 & 1) == 0) *(unsigned*)((char*)obf + (ro >> 1) + d0 * 64) = cvtpk(tot, vn); } } }
    __syncthreads();
#undef RESC
#undef KBASE
#undef ACT
#undef MASKT
#undef SEAM_K0
#undef HALF_STEP
}
#undef LDG16
#undef VMW
#undef VMWN
#undef SLOAD_H
#undef SWRITE_HK
#undef SWRITE_HV
#undef SWRITE_H

__device__ __forceinline__ void imp_item(char* lds, int tid, int b, int g, int tblk, const bf16* qraw, const bf16* kc  , const bf16* vc, const float* gate, float* oacc, unsigned* maskp  ) {
    asm volatile("" : "+v"(tid));
    const int wid = __builtin_amdgcn_readfirstlane(tid >> 6), lane = tid & 63, r32 = lane & 31, hi = lane >> 5;
    char* V_lds = lds; char* K_lds = lds + 2 * SHM_V;
    float* BT = (float*)(lds + 4 * SHM_V) + wid * 2048;
    { const int sr = tid >> 4, sc = (tid & 15) * 8, kws = KSWZ(sr, sc * 2), vst0 = v_st(sr, sc), vst1 = v_st(32 + sr, sc); const unsigned toff = (unsigned)(sr * D + sc) * 2u;
#pragma unroll
      for (int kt = 0; kt < 2; ++kt) { const char* kb_ = (const char*)kc + (size_t)(64 * kt) * (D * 2); const char* vb_ = (const char*)vc + (size_t)(64 * kt) * (D * 2);
          const bf16x8 k0 = *(const bf16x8*)(kb_ + toff), k1 = *(const bf16x8*)(kb_ + 32 * D * 2 + toff), v0 = *(const bf16x8*)(vb_ + toff), v1 = *(const bf16x8*)(vb_ + 32 * D * 2 + toff);
          *(bf16x8*)(K_lds + kt * SHM_K + kws) = k0; *(bf16x8*)(K_lds + kt * SHM_K + kws + 32 * 256) = k1; *(bf16x8*)(V_lds + kt * SHM_V + vst0) = v0; *(bf16x8*)(V_lds + kt * SHM_V + vst1) = v1; } }
    __syncthreads();
    const int vb0 = (int)(uintptr_t)V_lds + v_rd_base(lane);
    constexpr float C2 = 1.4426950408889634f * SCALE; const float NEG = -__builtin_inff();
#pragma nounroll
    for (int st = 0; st < 4; ++st) {
        const int tb = tblk * 256 + st * 64 + wid * 8;
        const int t = tb + (r32 >> 2), head = g * 4 + (r32 & 3); const unsigned rowq = (unsigned)(b * SKV + t);
        bf16x8 qr[8];
#pragma unroll
        for (int d0 = 0; d0 < 8; ++d0) qr[d0] = *(const bf16x8*)((const char*)qraw + ((size_t)rowq * 2048 + head * 128 + d0 * 16 + hi * 8) * 2);
        f32x16 pA0, pA1, pB0, pB1;
        qkt<0, false>(pA0, pA1, K_lds, r32, hi, qr, true); qkt<1, false>(pB0, pB1, K_lds, r32, hi, qr, true);
        const int cmax = (t - 31) >> 4;
        float mx = NEG;
#pragma unroll
        for (int r = 0; r < 16; ++r) { const int kk = crow(r, hi);
            pA0[r] = (kk <= cmax) ? pA0[r] : NEG; pA1[r] = (kk + 32 <= cmax) ? pA1[r] : NEG; pB0[r] = (kk + 64 <= cmax) ? pB0[r] : NEG; pB1[r] = (kk + 96 <= cmax) ? pB1[r] : NEG;
            mx = fmaxf(fmaxf(mx, fmaxf(pA0[r], pA1[r])), fmaxf(pB0[r], pB1[r])); }
        { unsigned a_ = __float_as_uint(mx), b_ = a_; swap32(a_, b_); mx = fmaxf(__uint_as_float(a_), __uint_as_float(b_)); }
        const float mL = (cmax >= 0) ? -mx * C2 : 0.f; float ps = 0.f;
#pragma unroll
        for (int r = 0; r < 16; ++r) { pA0[r] = __builtin_amdgcn_exp2f(fmaf(pA0[r], C2, mL)); pA1[r] = __builtin_amdgcn_exp2f(fmaf(pA1[r], C2, mL)); pB0[r] = __builtin_amdgcn_exp2f(fmaf(pB0[r], C2, mL)); pB1[r] = __builtin_amdgcn_exp2f(fmaf(pB1[r], C2, mL));
            ps += (pA0[r] + pA1[r]) + (pB0[r] + pB1[r]); }
        { unsigned a_ = __float_as_uint(ps), b_ = a_; swap32(a_, b_); ps = __uint_as_float(a_) + __uint_as_float(b_); }
        const float inv = ps > 0.f ? 1.0f / ps : 0.f;
        pA0 = pA0 * inv; pA1 = pA1 * inv; pB0 = pB0 * inv; pB1 = pB1 * inv;
        float* Bp = BT + r32 * 32; float* Tp = BT + 1024 + r32 * 32;
#pragma unroll
        for (int gq = 0; gq < 4; ++gq) {
            Bp[2 * gq + hi] = (pA0[4 * gq] + pA0[4 * gq + 1]) + (pA0[4 * gq + 2] + pA0[4 * gq + 3]); Tp[2 * gq + hi] = pA0[4 * gq + 3];
            Bp[8 + 2 * gq + hi] = (pA1[4 * gq] + pA1[4 * gq + 1]) + (pA1[4 * gq + 2] + pA1[4 * gq + 3]); Tp[8 + 2 * gq + hi] = pA1[4 * gq + 3];
            Bp[16 + 2 * gq + hi] = (pB0[4 * gq] + pB0[4 * gq + 1]) + (pB0[4 * gq + 2] + pB0[4 * gq + 3]); Tp[16 + 2 * gq + hi] = pB0[4 * gq + 3];
            Bp[24 + 2 * gq + hi] = (pB1[4 * gq] + pB1[4 * gq + 1]) + (pB1[4 * gq + 2] + pB1[4 * gq + 3]); Tp[24 + 2 * gq + hi] = pB1[4 * gq + 3]; }
        f32x16 o[4] = {};
        { bf16x8 pa0, pa1, pa2, pa3;
#define PK4I(P, B_, OUT) do { unsigned a0 = cvtpk(P[B_+0], P[B_+1]), a1 = cvtpk(P[B_+2], P[B_+3]), b0 = cvtpk(P[B_+4], P[B_+5]), b1 = cvtpk(P[B_+6], P[B_+7]); \
        swap32(a0, b0); swap32(a1, b1); u32x4 w_ = {a0, a1, b0, b1}; OUT = *reinterpret_cast<bf16x8*>(&w_); } while (0)
          PK4I(pA0, 0, pa0); PK4I(pA0, 8, pa1); PK4I(pA1, 0, pa2); PK4I(pA1, 8, pa3); pv_tile<0, false>(o, vb0, pa0, pa1, pa2, pa3, true);
          PK4I(pB0, 0, pa0); PK4I(pB0, 8, pa1); PK4I(pB1, 0, pa2); PK4I(pB1, 8, pa3); pv_tile<1, false>(o, vb0, pa0, pa1, pa2, pa3, true);
#undef PK4I
        }
#pragma unroll
        for (int r = 0; r < 16; ++r) { const int rp = crow(r, hi); const unsigned rowo = (unsigned)(b * SKV + tb + (rp >> 2)); const int hd = g * 4 + (rp & 3);
            const float gt = *(const float*)((const char*)gate + (rowo * 48u + (unsigned)(hd * 3)) * 4u); const unsigned ro = (rowo * 2048u + (unsigned)(hd * 128 + r32)) * 4u;
#pragma unroll
            for (int d0 = 0; d0 < 4; ++d0) *(float*)((char*)oacc + ro + d0 * 128) = o[d0][r] * gt; }
        asm volatile("s_waitcnt lgkmcnt(0)" ::: "memory");
#pragma unroll 1
        for (int pp = 0; pp < 4; ++pp) {
            const int tl = 2 * pp + hi, tt = tb + tl, j = r32; float imp = 0.f;
#pragma unroll
            for (int hh = 0; hh < 4; ++hh) { imp += BT[(4 * tl + hh) * 32 + j]; if (j > 0) imp += BT[1024 + (4 * tl + hh) * 32 + j - 1]; }
            const int qb = tt >> 6; const bool causal = j <= qb, forced = (j == 0) || (causal && j > qb - 2);
            const float val = forced ? 1e9f : (causal ? imp : -1.0f);
            int rank = 0;
#pragma unroll
            for (int o2 = 0; o2 < 32; ++o2) { const float vo = __builtin_bit_cast(float, __builtin_amdgcn_ds_bpermute((o2 + 32 * hi) * 4, __builtin_bit_cast(int, val))); rank += (vo > val || (vo == val && o2 < j)) ? 1 : 0; }
            const bool sel = (rank < 16) && (val >= 0.f);
            const unsigned long long bal = __ballot(sel);
            if (r32 == 0) maskp[tt] = hi ? (unsigned)(bal >> 32) : (unsigned)bal;
        }
        asm volatile("s_waitcnt lgkmcnt(0)" ::: "memory");
    }
    __syncthreads();
}
#undef KSWZ
#undef SBAR
}

constexpr int NWAVES = 8;
constexpr int NB = 8, S = 2048, D = 2048, M = NB * S, FF = 5632, NMODC = 9 * D, DEPTH = 4;
constexpr int NSA_SRC = 5168, NSA_N = 5120, ML_SRC = 6160, ML_N = 6144;
constexpr float RMS_EPS = 1e-6f;

constexpr size_t MiB = 1u << 20;
constexpr size_t WS_CTL = 0, CTL_ZERO_BYTES = 1 * MiB;
constexpr size_t WS_MOD = 1 * MiB;
constexpr size_t WS_ROPE = 4 * MiB;
constexpr size_t WS_CBIAS = 5 * MiB;
constexpr size_t WS_MASK = 6 * MiB;
constexpr size_t WS_GATE = 7 * MiB;
constexpr size_t WS_KCVC = 10 * MiB;
constexpr size_t WS_CHID = 14 * MiB;
constexpr size_t WS_WC2 = 24 * MiB;
constexpr size_t WS_WG = 23 * MiB;
constexpr size_t WS_W = 32 * MiB;
constexpr size_t W_FFIN = 44 * MiB, W_FFOUT = 22 * MiB, W_NSAIN = 20 * MiB, W_CW1 = 4 * MiB, W_SQ = 8 * MiB, W_MLIN = 24 * MiB;
constexpr size_t WS_W_FFIN = WS_W;
constexpr size_t WS_W_FFOUT = WS_W_FFIN + 8 * W_FFIN;
constexpr size_t WS_W_NSAIN = WS_W_FFOUT + 8 * W_FFOUT;
constexpr size_t WS_W_CW1 = WS_W_NSAIN + 2 * W_NSAIN;
constexpr size_t WS_W_NSAOUT = WS_W_CW1 + 4 * W_CW1;
constexpr size_t WS_W_MLIN = WS_W_NSAOUT + 2 * W_SQ;
constexpr size_t WS_W_MLOUT = WS_W_MLIN + 2 * W_MLIN;
constexpr size_t WS_H = WS_W_MLOUT + 2 * W_SQ;
constexpr size_t WS_HID = WS_H + 64 * MiB;
constexpr size_t WS_Y = WS_HID + 176 * MiB;
constexpr size_t WS_O = WS_Y + 128 * MiB;
constexpr size_t WS_QRAW = WS_O + 64 * MiB, WS_QROT = WS_QRAW + 64 * MiB;
constexpr size_t WS_KV = WS_QROT + 64 * MiB;
constexpr size_t KV_STRIDE = 16 * MiB / 2;
constexpr size_t WS_OACC = WS_KV + 97 * MiB;
constexpr size_t WS_MLQ = WS_OACC + 128 * MiB;
constexpr size_t WS_END = WS_MLQ + 192 * MiB;
static_assert(WS_H == (32 + 352 + 176 + 40 + 16 + 16 + 48 + 16) * MiB, "weight map");

constexpr int CW_BAR = 4096;
constexpr int NPHASES_DEV = 1 + 2 * 13 + 2 * 10 + 1;

constexpr int RING_BYTES = 131072;
constexpr int LDSCTL_OFF = RING_BYTES, MISC_OFF = LDSCTL_OFF + 320;
constexpr int LDS_BYTES = 147456;

#define GAS __attribute__((address_space(1)))
#define LAS __attribute__((address_space(3)))
typedef unsigned short bf16;
typedef float f32x4 __attribute__((ext_vector_type(4)));
typedef float f32x2 __attribute__((ext_vector_type(2)));
typedef unsigned v4u __attribute__((ext_vector_type(4)));
typedef unsigned v2u __attribute__((ext_vector_type(2)));
#define LDS_WAIT() asm volatile("s_waitcnt lgkmcnt(0)" ::: "memory")
__device__ __forceinline__ unsigned f2bf(float f) { unsigned u = __builtin_bit_cast(unsigned, f); return (u + 0x7fffu + ((u >> 16) & 1u)) >> 16; }
__device__ __forceinline__ unsigned pk2(float lo, float hi) { return f2bf(lo) | (f2bf(hi) << 16); }
__device__ __forceinline__ float bf2f(unsigned b) { return __builtin_bit_cast(float, b << 16); }
__device__ __forceinline__ float bflo(unsigned w) { return __builtin_bit_cast(float, w << 16); }
__device__ __forceinline__ float bfhi(unsigned w) { return __builtin_bit_cast(float, w & 0xffff0000u); }
template <int K> __device__ __forceinline__ float xor_lane(float v) { return __builtin_bit_cast(float, __builtin_amdgcn_ds_swizzle(__builtin_bit_cast(int, v), (K << 10) | 0x1f)); }
__device__ __forceinline__ void swap32(unsigned& a, unsigned& b) { asm volatile("s_nop 1\n\tv_permlane32_swap_b32 %0, %1\n\ts_nop 1" : "+v"(a), "+v"(b)); }
__device__ __forceinline__ float wave_sum(float v) {
    v += xor_lane<1>(v); v += xor_lane<2>(v); v += xor_lane<4>(v); v += xor_lane<8>(v); v += xor_lane<16>(v);
    unsigned a = __builtin_bit_cast(unsigned, v), c = a; swap32(a, c);
    return __builtin_bit_cast(float, a) + __builtin_bit_cast(float, c);
}
__device__ __forceinline__ float wave_max(float v) {
    v = fmaxf(v, xor_lane<1>(v)); v = fmaxf(v, xor_lane<2>(v)); v = fmaxf(v, xor_lane<4>(v)); v = fmaxf(v, xor_lane<8>(v)); v = fmaxf(v, xor_lane<16>(v));
    unsigned a = __builtin_bit_cast(unsigned, v), c = a; swap32(a, c);
    return fmaxf(__builtin_bit_cast(float, a), __builtin_bit_cast(float, c));
}

#define XB_TMO      128
#define XB_XCNT(j)  (256  + 64 * (j))
#define XB_XSUB(j)  (1280 + 64 * (j))
#define XB_XGEN(j)  (2304 + 64 * (j))
#define XB_TOP      3328
#define XB_TOPGEN   3392
#define XB_LSUB(j)  (3456 + 64 * (j))
#define XB_LGEN(j)  (4480 + 64 * (j))
#define XCD_BAR_WORDS 5504
#define XB_SPIN_CAP (1u << 22)
__device__ __forceinline__ unsigned xb_ld(unsigned* p)              { return __hip_atomic_load(p, __ATOMIC_RELAXED, __HIP_MEMORY_SCOPE_AGENT); }
__device__ __forceinline__ unsigned xb_add(unsigned* p, unsigned v) { return __hip_atomic_fetch_add(p, v, __ATOMIC_RELAXED, __HIP_MEMORY_SCOPE_AGENT); }
__device__ __forceinline__ unsigned xb_xcc_id() { return (unsigned)__builtin_amdgcn_s_getreg((3 << 11) | 20) & 0xFu; }
#define XB_SPIN(cond, bar) do { unsigned _sp = 0; while (cond) { __builtin_amdgcn_s_sleep(1); \
    if ((++_sp & 255u) == 0u) { if (xb_ld(&(bar)[XB_TMO])) break; if (_sp > XB_SPIN_CAP) { atomicAdd(&(bar)[XB_TMO], 1u); break; } } } } while (0)
__device__ __forceinline__ int lane_id();
struct XcdBarrier { unsigned* bar; unsigned x; volatile LAS unsigned* st; int w; };
__device__ __forceinline__ XcdBarrier xcd_barrier_post(unsigned* bar, volatile LAS unsigned* st, int wave_s) {
    XcdBarrier b; b.bar = bar; b.x = xb_xcc_id(); b.st = st; b.w = wave_s;
    if (wave_s == 0 && lane_id() == 0) st[2] = xb_add(&bar[XB_XCNT(b.x)], 1u);
    return b;
}
__device__ __forceinline__ void xcd_barrier_complete(unsigned* bar, unsigned x, unsigned& nloc, unsigned& nx, unsigned& xi, unsigned& balanced) {
    const unsigned G = gridDim.x * gridDim.y * gridDim.z;
    unsigned sum, cnt, mine, below, same, sp = 0u;
    for (;;) {
        sum = 0u; cnt = 0u; mine = 0u; below = 0u; same = 1u;
#pragma unroll
        for (unsigned j = 0; j < 16; ++j) { const unsigned c = xb_ld(&bar[XB_XCNT(j)]); sum += c; cnt += (c > 0u) ? 1u : 0u; mine = (j == x) ? c : mine; below += (j < x && c > 0u) ? 1u : 0u; same &= (c == 0u || c == 32u) ? 1u : 0u; }
        if (sum == G) break;
        __builtin_amdgcn_s_sleep(1);
        if ((++sp & 255u) == 0u) { if (xb_ld(&bar[XB_TMO])) break; if (sp > XB_SPIN_CAP) { atomicAdd(&bar[XB_TMO], 1u); break; } }
    }
    nloc = mine > 0u ? mine : 1u; nx = cnt > 0u ? cnt : 1u; xi = below; balanced = (sum == G && cnt == 8u && same) ? 1u : 0u;
}
__device__ __forceinline__ void xcd_barrier(const XcdBarrier& b) {
    asm volatile("s_waitcnt vmcnt(0)" ::: "memory");
    __syncthreads();
    if (b.w == 0 && lane_id() == 0) {
        size_t bz = 0; asm volatile("" : "+s"(bz)); unsigned* bar = b.bar + bz;
        __builtin_amdgcn_s_waitcnt(0);
        unsigned nloc = b.st[0], nx = b.st[1];
        if (nloc == 0u) { unsigned xi, bal; xcd_barrier_complete(bar, b.x, nloc, nx, xi, bal); b.st[0] = nloc; b.st[1] = nx; b.st[3] = xi; b.st[4] = bal; }
        const unsigned old = xb_add(&bar[XB_XSUB(b.x)], 1u);
        const unsigned gen = old / nloc;
        if (old + 1u == (gen + 1u) * nloc) {
            __builtin_amdgcn_fence(__ATOMIC_RELEASE, "agent");
            asm volatile("s_waitcnt vmcnt(0)" ::: "memory");
            const unsigned og = xb_add(&bar[XB_TOP], 1u);
            const unsigned tg = og / nx;
            if (og + 1u == (tg + 1u) * nx) xb_add(&bar[XB_TOPGEN], 1u);
            else XB_SPIN(xb_ld(&bar[XB_TOPGEN]) == tg, bar);
            __builtin_amdgcn_fence(__ATOMIC_ACQUIRE, "agent");
            xb_add(&bar[XB_XGEN(b.x)], 1u);
            asm volatile("s_waitcnt vmcnt(0)" ::: "memory");
        } else {
            XB_SPIN(xb_ld(&bar[XB_XGEN(b.x)]) == gen, bar);
            __builtin_amdgcn_fence(__ATOMIC_ACQUIRE, "agent");
            asm volatile("s_waitcnt vmcnt(0)" ::: "memory");
        }
    }
    __syncthreads();
}

__device__ __forceinline__ void xcd_barrier_local(const XcdBarrier& b) {
    asm volatile("s_waitcnt vmcnt(0)" ::: "memory");
    __syncthreads();
    if (b.w == 0 && lane_id() == 0) {
        size_t bz = 0; asm volatile("" : "+s"(bz)); unsigned* bar = b.bar + bz;
        __builtin_amdgcn_s_waitcnt(0);
        const unsigned nloc = b.st[0];
        const unsigned old = xb_add(&bar[XB_LSUB(b.x)], 1u);
        const unsigned gen = old / nloc;
        if (old + 1u == (gen + 1u) * nloc) xb_add(&bar[XB_LGEN(b.x)], 1u);
        else XB_SPIN(xb_ld(&bar[XB_LGEN(b.x)]) == gen, bar);
        __builtin_amdgcn_fence(__ATOMIC_ACQUIRE, "agent");
        asm volatile("s_waitcnt vmcnt(0)" ::: "memory");
    }
    __syncthreads();
}

struct Args { const float* in[20]; float* out; unsigned char* ws; int ph_lo, ph_hi; };
struct Frame {
    LAS unsigned char* lds;
    int tid, lane, wave, G, wg;
    int b0, b1, local;
    int gwg, gG;
};

struct DomOrder {
    pg8::StaticOrder so; int local, r, n, pm0, nunits;
    __device__ __forceinline__ void init(int Mg, int N, const Frame& F) { local = F.local; so.init(Mg, N, F.G, F.wg); r = F.wg; n = F.G; pm0 = 8 * F.b0; nunits = 8 * (N / 256); }
    __device__ __forceinline__ bool next(int i, pg8::Unit& u) const {
        if (!local) return so.next(i, u);
        const int L = i * n + r; if (L >= nunits) return false;
        u.pm = pm0 + (L & 7); u.pn = L >> 3; return true;
    }
    __device__ __forceinline__ void a_ready(const pg8::Unit&) const {}
    __device__ __forceinline__ void done(const pg8::Unit&) const {}
};
struct OneUnit {
    int pm, pn, valid;
    __device__ __forceinline__ bool next(int i, pg8::Unit& u) const { if (i != 0 || !valid) return false; u.pm = pm; u.pn = pn; return true; }
    __device__ __forceinline__ void a_ready(const pg8::Unit&) const {}
    __device__ __forceinline__ void done(const pg8::Unit&) const {}
};
__device__ __forceinline__ void sincos_small(double x, double& s, double& c) {
    const double x2 = x * x; double ts = x, tc = 1.0; s = x; c = 1.0;
#pragma unroll
    for (int k = 1; k <= 12; ++k) { tc = -tc * x2 / (double)((2 * k - 1) * (2 * k)); ts = -ts * x2 / (double)((2 * k) * (2 * k + 1)); c += tc; s += ts; }
}
__device__ __forceinline__ void rope_table(const Frame& F, float* cs, float* sn, double r  ) {
    for (int idx = F.wg * 512 + F.tid; idx < S * 64; idx += F.G * 512) {
        const int pos = idx >> 6, i = idx & 63;
        double f = 1.0; for (int k = 0; k < i; ++k) f *= r;
        double bs, bc; sincos_small(f, bs, bc);
        double rs = 0.0, rc = 1.0;
        for (int bit = 0; bit < 11; ++bit) {
            if ((pos >> bit) & 1) { const double nc = rc * bc - rs * bs, ns = rc * bs + rs * bc; rc = nc; rs = ns; }
            const double c2 = bc * bc - bs * bs, s2 = 2.0 * bs * bc; bc = c2; bs = s2;
        }
        cs[idx] = (float)rc; sn[idx] = (float)rs;
    }
}
template <int MAP> __device__ __forceinline__ int colmap(int i, int col0, int cmax) {
    if (MAP == 1) { const int pn = i >> 8, half = (i >> 7) & 1, j = i & 127; return half * FF + 128 * pn + j; }
    if (MAP == 2) { const int hb = i >> 7, ii = i & 127; return hb * 128 + 64 * ((ii >> 2) & 1) + 4 * (ii >> 3) + (ii & 3); }
    if (MAP == 3) return i;
    const int c = col0 + i; return c < cmax ? c : cmax;
}
template <int MAP> __device__ __forceinline__ void conv_item(const float* W, int ldw, int K, int N, bf16* WT, LAS float* scr, int item, int lane, int col0, int cmax) {
    const int nblk = N / 32, kb = item / nblk, nb = item % nblk, k0 = 64 * kb, n0 = 32 * nb;
    const int scol = colmap<MAP>(n0 + (lane & 31), col0, cmax);
#pragma unroll 8
    for (int i = 0; i < 32; ++i) { const int kk = 2 * i + (lane >> 5); scr[kk * 33 + (lane & 31)] = W[(size_t)(k0 + kk) * ldw + scol]; }
    LDS_WAIT(); asm volatile("" ::: "memory");
    const int c = lane & 7;
#pragma unroll
    for (int j = 0; j < 4; ++j) { const int n = (lane >> 3) + 8 * j; const LAS float* s = scr + (8 * c) * 33 + n;
        v4u o; o.x = pk2(s[0 * 33], s[1 * 33]); o.y = pk2(s[2 * 33], s[3 * 33]); o.z = pk2(s[4 * 33], s[5 * 33]); o.w = pk2(s[6 * 33], s[7 * 33]);
        *(v4u*)(WT + (size_t)(n0 + n) * K + k0 + 8 * c) = o; }
    LDS_WAIT(); asm volatile("" ::: "memory");
}
template <int MAP> __device__ __forceinline__ void conv_item_v(const float* W, int ldw, int K, int N, bf16* WT, LAS float* scr, int item, int lane) {
    const int nblk = N / 64, kb = item / nblk, nb = item % nblk, k0 = 32 * kb, n0 = 64 * nb, c4 = (lane & 15) * 4, rs = lane >> 4;
    const int scol = colmap<MAP>(n0 + c4, 0, 0x7fffffff);
    f32x4 v[8];
#pragma unroll
    for (int i = 0; i < 8; ++i) v[i] = *(const f32x4*)(W + (size_t)(k0 + 4 * i + rs) * ldw + scol);
#pragma unroll
    for (int i = 0; i < 8; ++i) { LAS float* d = scr + (4 * i + rs) * 65 + c4; d[0] = v[i].x; d[1] = v[i].y; d[2] = v[i].z; d[3] = v[i].w; }
    LDS_WAIT(); asm volatile("" ::: "memory");
    const int c = lane & 3;
#pragma unroll
    for (int j = 0; j < 4; ++j) { const int n = (lane >> 2) + 16 * j; const LAS float* s = scr + (8 * c) * 65 + n;
        v4u o; o.x = pk2(s[0 * 65], s[1 * 65]); o.y = pk2(s[2 * 65], s[3 * 65]); o.z = pk2(s[4 * 65], s[5 * 65]); o.w = pk2(s[6 * 65], s[7 * 65]);
        *(v4u*)(WT + (size_t)(n0 + n) * K + k0 + 8 * c) = o; }
    LDS_WAIT(); asm volatile("" ::: "memory");
}
template <int MAP> __device__ __forceinline__ void conv_matrix_v(const Frame& F, const float* W, int ldw, int K, int N, bf16* WT) {
    LAS float* scr = (LAS float*)(F.lds + F.wave * 16384);
    const int gw = F.wg * NWAVES + F.wave, NGW = F.G * NWAVES, items = (K / 32) * (N / 64);
    for (int it = gw; it < items; it += NGW) conv_item_v<MAP>(W, ldw, K, N, WT, scr, it, F.lane);
}
template <int MAP> __device__ __forceinline__ void conv_matrix(const Frame& F, const float* W, int ldw, int K, int N, bf16* WT, int col0, int cmax) {
    LAS float* scr = (LAS float*)(F.lds + F.wave * 16384);
    const int gw = F.wg * NWAVES + F.wave, NGW = F.G * NWAVES, items = (K / 64) * (N / 32);
    for (int it = gw; it < items; it += NGW) conv_item<MAP>(W, ldw, K, N, WT, scr, it, F.lane, col0, cmax);
}
__device__ __forceinline__ void mod_phase(const Frame& F, const float* c, const float* mw, const float* mb, float* mod, int l0, int nl, int wg0, int nwg) {
    LAS float* ca = (LAS float*)F.lds;
    LAS float* red = (LAS float*)(F.lds + 65536);
    for (int i = F.tid; i < NB * D; i += 512) { const float v = c[i]; ca[i] = v / (1.0f + __expf(-v)); }
    __syncthreads();
    const int nunits = nl * (NMODC / 64);
    for (int u = F.wg - wg0; u < nunits; u += nwg) {
        const int l = l0 + u / (NMODC / 64), cb = u % (NMODC / 64), col = cb * 64 + F.lane;
        const float* wp = mw + (size_t)l * D * NMODC + col;
        float a0[8];
#pragma unroll
        for (int b = 0; b < 8; ++b) a0[b] = 0.f;
        const int kbeg = F.wave * 256;
#pragma unroll 16
        for (int k = kbeg; k < kbeg + 256; ++k) {
            const float w = wp[(size_t)k * NMODC];
#pragma unroll
            for (int b = 0; b < 8; ++b) a0[b] += ca[b * D + k] * w;
        }
#pragma unroll
        for (int b = 0; b < 8; ++b) red[(F.wave * 8 + b) * 64 + F.lane] = a0[b];
        __syncthreads();
        { const int b = F.tid >> 6, j = F.tid & 63; float s = 0.f;
#pragma unroll
            for (int w = 0; w < 8; ++w) s += red[(w * 8 + b) * 64 + j];
            mod[((size_t)l * NB + b) * NMODC + cb * 64 + j] = s + mb[(size_t)l * NMODC + cb * 64 + j]; }
        __syncthreads();
    }
}
__device__ __forceinline__ void cbias_phase(const Frame& F, const float* pe, const float* w1, float* cb) {
    const int u = F.wg - (F.G - 32); if (u < 0) return;
    const int lt = u >> 3, n = (u & 7) * 64 + F.lane; LAS float* red = (LAS float*)F.lds;
    const float* p = pe + (size_t)lt * 4096 + F.wave * 512; const float* w = w1 + ((size_t)lt * 4096 + F.wave * 512) * 512 + n;
    float acc = 0.f;
#pragma unroll 16
    for (int k = 0; k < 512; ++k) acc += p[k] * w[(size_t)k * 512];
    red[F.wave * 64 + F.lane] = acc;
    __syncthreads();
    if (F.wave == 0) { float s = 0.f;
#pragma unroll
        for (int w8 = 0; w8 < 8; ++w8) s += red[w8 * 64 + F.lane];
        cb[lt * 512 + n] = s; }
    __syncthreads();
}

struct ThinArgs { const float* xin; float* xout; const bf16* Y; float coef; const float* gate; const float* gpost; const float* gpre; const float* shift; const float* scale; bf16* H; int pend, pre; };
__device__ __forceinline__ void thin_phase(const Frame& F, const ThinArgs& a) {
    const int gw = F.wg * NWAVES + F.wave, NGW = F.G * NWAVES;
    for (int blk = gw; blk < (F.b1 - F.b0) * 256; blk += NGW) {
        const int row0 = (F.b0 * 256 + blk) * 8, b = row0 >> 11; const size_t bo = (size_t)b * NMODC + 4 * F.lane;
        f32x4 va[8], vp[8], vs[8];
        if (a.pend) {
#pragma unroll
            for (int j = 0; j < 8; ++j) va[j] = *(const f32x4*)(a.gate + bo + 256 * j) * *(const f32x4*)(a.gpost + 4 * F.lane + 256 * j) * a.coef;
        }
        if (a.pre) {
#pragma unroll
            for (int j = 0; j < 8; ++j) { vp[j] = *(const f32x4*)(a.gpre + 4 * F.lane + 256 * j) * (*(const f32x4*)(a.scale + bo + 256 * j) + 1.0f); vs[j] = *(const f32x4*)(a.shift + bo + 256 * j); }
        }
#pragma unroll 2
        for (int r = 0; r < 8; ++r) {
            const size_t ro = (size_t)(row0 + r) * D + 4 * F.lane;
            f32x4 x[8];
#pragma unroll
            for (int j = 0; j < 8; ++j) x[j] = *(const f32x4*)(a.xin + ro + 256 * j);
            if (a.pend) {
                f32x4 y[8]; float ss = 0.f;
#pragma unroll
                for (int j = 0; j < 8; ++j) { const v2u yw = *(const v2u*)(a.Y + ro + 256 * j); y[j] = (f32x4){bflo(yw.x), bfhi(yw.x), bflo(yw.y), bfhi(yw.y)}; ss += (y[j].x * y[j].x + y[j].y * y[j].y) + (y[j].z * y[j].z + y[j].w * y[j].w); }
                const float rr = rsqrtf(wave_sum(ss) * (1.0f / D) + RMS_EPS);
#pragma unroll
                for (int j = 0; j < 8; ++j) x[j] = x[j] + (y[j] * rr) * va[j];
            }
#pragma unroll
            for (int j = 0; j < 8; ++j) *(f32x4*)(a.xout + ro + 256 * j) = x[j];
            if (a.pre) {
                float ss = 0.f;
#pragma unroll
                for (int j = 0; j < 8; ++j) ss += (x[j].x * x[j].x + x[j].y * x[j].y) + (x[j].z * x[j].z + x[j].w * x[j].w);
                const float rr = rsqrtf(wave_sum(ss) * (1.0f / D) + RMS_EPS);
#pragma unroll
                for (int j = 0; j < 8; ++j) { const f32x4 h = (x[j] * rr) * vp[j] + vs[j];
                    v2u w; w.x = pk2(h.x, h.y); w.y = pk2(h.z, h.w); *(v2u*)(a.H + ro + 256 * j) = w; }
            }
        }
    }
}

template <int MODE, int NT> __device__ __forceinline__ void thin_proj(const Frame& F, const bf16* H, const bf16* Wt, const float* gb, float* out, int ldo) {
    typedef short bf16x8v __attribute__((ext_vector_type(8)));
    const int gw = F.wg * NWAVES + F.wave, NGW = F.G * NWAVES, fr = F.lane & 15, fq = F.lane >> 4;
    for (int rt0 = gw; rt0 < (F.b1 - F.b0) * 128; rt0 += NGW) {
        const int rt = F.b0 * 128 + rt0;
        f32x4 acc[NT];
#pragma unroll
        for (int n = 0; n < NT; ++n) acc[n] = (f32x4){0.f, 0.f, 0.f, 0.f};
        const bf16* ap = H + (size_t)(rt * 16 + fr) * D + fq * 8; const bf16* bp = Wt + (size_t)fr * D + fq * 8;
#pragma unroll 8
        for (int k0 = 0; k0 < D; k0 += 32) {
            const bf16x8v a = *(const bf16x8v*)(ap + k0);
#pragma unroll
            for (int n = 0; n < NT; ++n) { const bf16x8v bv = *(const bf16x8v*)(bp + (size_t)n * 16 * D + k0); acc[n] = __builtin_amdgcn_mfma_f32_16x16x32_bf16(bv, a, acc[n], 0, 0, 0); }
        }
#pragma unroll
        for (int n = 0; n < NT; ++n) { f32x4 v = acc[n];
            if (MODE == 0) {
#pragma unroll
                for (int e = 0; e < 4; ++e) v[e] = 1.0f / (1.0f + __expf(-v[e])); }
            else { const f32x4 bb = *(const f32x4*)(gb + 4 * fq); v = v + bb;
                if (fq >= 2) {
#pragma unroll
                    for (int e = 0; e < 4; ++e) { const float ex = __expf(-fabsf(v[e])); const float l1p = ex < 0.01f ? ex * (1.0f - ex * (0.5f - ex * 0.33333334f)) : __logf(1.0f + ex); v[e] = fminf(v[e], 0.f) - l1p; } } }
            *(f32x4*)(out + (size_t)(rt * 16 + fr) * ldo + 16 * n + 4 * fq) = v; }
    }
}

__device__ __forceinline__ void cmp2_mfma(const Frame& F, const bf16* hid  , const bf16* w2t  , bf16* kcvc  ) {
    typedef short bf16x8v __attribute__((ext_vector_type(8)));
    const int gw = F.wg * NWAVES + F.wave, NGW = F.G * NWAVES, fr = F.lane & 15, fq = F.lane >> 4;
    const int ntile = (F.b1 - F.b0) * 32;
    for (int task = gw; task < 2 * ntile; task += NGW) {
        const int t = task / ntile, rt = F.b0 * 32 + task % ntile, row = rt * 16 + fr;
        f32x4 acc[8];
#pragma unroll
        for (int n = 0; n < 8; ++n) acc[n] = (f32x4){0.f, 0.f, 0.f, 0.f};
        const bf16* ap = hid + ((size_t)t * 4096 + row) * 512 + fq * 8; const bf16* bp = w2t + ((size_t)t * 128 + fr) * 512 + fq * 8;
#pragma unroll 2
        for (int k0 = 0; k0 < 512; k0 += 32) {
            const bf16x8v a = *(const bf16x8v*)(ap + k0);
#pragma unroll
            for (int n = 0; n < 8; ++n) { const bf16x8v bv = *(const bf16x8v*)(bp + (size_t)n * 16 * 512 + k0); acc[n] = __builtin_amdgcn_mfma_f32_16x16x32_bf16(bv, a, acc[n], 0, 0, 0); }
        }
        const bool zr = (row & 127) == 127;
#pragma unroll
        for (int n = 0; n < 8; ++n) { const f32x4 v = zr ? (f32x4){0.f, 0.f, 0.f, 0.f} : acc[n];
            *(v2u*)(kcvc + ((size_t)t * 4096 + row) * 128 + 16 * n + 4 * fq) = (v2u){pk2(v[0], v[1]), pk2(v[2], v[3])}; }
    }
}
__device__ __forceinline__ void imp_phase_mfma(const Frame& F, char* lds, const bf16* qraw, const bf16* kc, const bf16* vc, const float* gate, float* oacc, unsigned* mask) {
    const int vcu = (!F.local && F.G % 8 == 0) ? (F.wg % 8) * (F.G / 8) + F.wg / 8 : F.wg;
    for (int v = vcu; v < (F.b1 - F.b0) * 32; v += F.G) {
        const int bg = 4 * F.b0 + (v >> 3), tblk = v & 7;
        att::imp_item(lds, F.tid, bg >> 2, bg & 3, tblk, qraw, kc + (size_t)bg * 128 * 128, vc + (size_t)bg * 128 * 128, gate, oacc, mask + bg * S);
    }
}
__device__ __forceinline__ void att_phase_mfma(const Frame& F, char* lds, const bf16* qrot, const bf16* kv, const float* gate, float* oacc, const unsigned* mask, bf16* O) {
    const int vcu = (!F.local && F.G % 8 == 0) ? (F.wg % 8) * (F.G / 8) + F.wg / 8 : F.wg;
    for (int v = vcu; v < (F.b1 - F.b0) * 32; v += F.G) {
        const int bg = 4 * F.b0 + (v >> 3), r = (v >> 1) & 3, half = v & 1, b = bg >> 2, g = bg & 3, head = g * 4 + r;
        const unsigned qlist = half ? 0x5261u : 0x4370u;
        const bf16* Qh = qrot + (size_t)(b * 16 + head) * S * 128;
        const bf16* Ks = kv + 2 * KV_STRIDE + (size_t)bg * S * 128; const bf16* Vs = kv + 3 * KV_STRIDE + (size_t)bg * S * 128;
        const bf16* Kw = kv + 4 * KV_STRIDE + (size_t)bg * S * 128; const bf16* Vw = kv + 5 * KV_STRIDE + (size_t)bg * S * 128;
        const unsigned* msk = mask + bg * S;
        att::Seam Sm;
        { const int qb0 = qlist & 15; const att::BlockRef c0{Qh + (size_t)qb0 * 256 * 128, Ks, Vs, qb0 * 256, b * S + qb0 * 256}; att::att_prime(c0, 1 << 24, lds, Sm, F.tid); }
#pragma nounroll
        for (int i = 0; i < 4; ++i) {
            const int qb = (qlist >> (4 * i)) & 15, qbn = (qlist >> (4 * ((i + 1) & 3))) & 15;
            const att::BlockRef bs{Qh + (size_t)qb * 256 * 128, Ks, Vs, qb * 256, b * S + qb * 256};
            const att::BlockRef bw{Qh + (size_t)qb * 256 * 128, Kw, Vw, qb * 256, b * S + qb * 256};
            const att::BlockRef bn{Qh + (size_t)qbn * 256 * 128, Ks, Vs, qbn * 256, b * S + qbn * 256};
            att::att_block<0>(bs, bw, 512, lds, Sm, F.tid, head, gate, oacc, O, msk);
            att::att_block<1>(bw, bn, 1 << 24, lds, Sm, F.tid, head, gate, oacc, O, msk);
        }
    }
}

#define LBAR() do { asm volatile("s_waitcnt lgkmcnt(0)" ::: "memory"); __builtin_amdgcn_s_barrier(); asm volatile("" ::: "memory"); } while (0)
namespace mlc {
typedef short bf16x8 __attribute__((ext_vector_type(8)));
typedef short bf16x4 __attribute__((ext_vector_type(4)));
typedef float f32x16 __attribute__((ext_vector_type(16)));
constexpr int QS = 0, KS = 17408, KGT = 34816, VST = 53248, PS = 90112, VEC = 99328;
constexpr int QLD = 136, TLD = 72, HLD = 264;
__device__ __forceinline__ unsigned cvtpk(float lo, float hi) { unsigned r; asm volatile("v_cvt_pk_bf16_f32 %0, %1, %2" : "=v"(r) : "v"(lo), "v"(hi)); return r; }
__device__ __forceinline__ int crow(int r, int hi) { return (r & 3) + 8 * (r >> 2) + 4 * hi; }
}
__device__ __forceinline__ void mlstm_cell_mfma(const Frame& F, const bf16* qkvo  , const float* mlg  , const float* convw  , const float* convb, const float* mhg, bf16* O) {
    using namespace mlc;
    LAS unsigned char* L = F.lds; LAS float* V = (LAS float*)(L + VEC);
    const int w = F.wave, lane0 = F.lane, tid = F.tid;
    const int quarter = w >> 1, cp0 = (w & 1) * 64 + lane0;
    for (int item = F.wg; item < (F.b1 - F.b0) * 8; item += F.G) {
        const int b = F.b0 + (item >> 3), h = item & 7;
        f32x16 Ct[4];
#pragma unroll
        for (int kt = 0; kt < 4; ++kt) Ct[kt] = f32x16{};
        if (tid < 256) V[1344 + tid] = 0.f;
        float m_prev = 0.f;
        const int qkcol0 = (cp0 < 64) ? (h * 128 + 2 * cp0) : (1024 + h * 128 + 2 * (cp0 - 64));
        const f32x2 cw0 = *(const f32x2*)(convw + qkcol0), cw1 = *(const f32x2*)(convw + 2048 + qkcol0), cw2 = *(const f32x2*)(convw + 4096 + qkcol0), cw3 = *(const f32x2*)(convw + 6144 + qkcol0), cbv = *(const f32x2*)(convb + qkcol0);
        const bf16* xb = qkvo + (size_t)b * S * 6144;
        unsigned xp[19], vq[16]; float gi_n = 0.f, gl_n = 0.f;
#define ML_ISSUE(cn, qc_, vc_) do { const int cn_ = (cn) < 32 ? (cn) : 31, r0n_ = cn_ * 64 + 16 * quarter; const bool hist_ = r0n_ >= 3;                    \
            const bf16* xh_ = xb + (size_t)(hist_ ? r0n_ - 3 : 0) * 6144; const bf16* xrn_ = xb + (size_t)r0n_ * 6144;                                       \
            { const unsigned h0_ = *(const unsigned*)(xh_ + (qc_)), h1_ = *(const unsigned*)(xh_ + 6144 + (qc_)), h2_ = *(const unsigned*)(xh_ + 2 * 6144 + (qc_)); \
              xp[0] = hist_ ? h0_ : 0u; xp[1] = hist_ ? h1_ : 0u; xp[2] = hist_ ? h2_ : 0u; }                                                                 \
            _Pragma("unroll") for (int ii_ = 0; ii_ < 16; ++ii_) xp[3 + ii_] = *(const unsigned*)((xrn_ + ii_ * 6144) + (qc_));                              \
            _Pragma("unroll") for (int ii_ = 0; ii_ < 16; ++ii_) vq[ii_] = *(const unsigned*)((xrn_ + ii_ * 6144) + (vc_)); } while (0)
        ML_ISSUE(0, (unsigned)qkcol0, (unsigned)(2048 + h * 256 + 2 * cp0));
#define ML_GATE_PREP(cn, ln_) do { LAS float* Vn_ = V + ((cn) & 1) * 512;                                                                      \
            const float ig = gi_n, lf = gl_n;                                                                                                \
            { const size_t grow = (size_t)(b * S + ((cn) < 31 ? (cn) * 64 + 64 : (cn) * 64) + (ln_)) * 16; gi_n = mlg[grow + h]; gl_n = mlg[grow + 8 + h]; }   \
            float bs = lf;                                                                                                                   \
            _Pragma("unroll") for (int d = 1; d < 64; d <<= 1) { const float o = __shfl_up(bs, d); if ((ln_) >= d) bs += o; }              \
            const float a = ig - bs; float A = a;                                                                                            \
            _Pragma("unroll") for (int d = 1; d < 64; d <<= 1) { const float o = __shfl_up(A, d); if ((ln_) >= d) A = fmaxf(A, o); }       \
            const float Mi = fmaxf(m_prev, A);                                                                                               \
            const float A63 = __shfl(A, 63), b63 = __shfl(bs, 63); const float M63 = fmaxf(m_prev, A63);                                   \
            Vn_[(ln_)] = bs; Vn_[64 + (ln_)] = a; Vn_[128 + (ln_)] = A; Vn_[192 + (ln_)] = Mi; Vn_[256 + (ln_)] = __expf(m_prev - Mi); Vn_[320 + (ln_)] = __expf(-(bs + Mi)); Vn_[384 + (ln_)] = __expf(a - M63); \
            if ((ln_) == 0) Vn_[448] = __expf(m_prev - M63);                                                                                \
            m_prev = b63 + M63; } while (0)
        if (w == 7) { const size_t g0 = (size_t)(b * S + lane0) * 16; gi_n = mlg[g0 + h]; gl_n = mlg[g0 + 8 + h]; ML_GATE_PREP(0, lane0); }
        LBAR();
#pragma nounroll
        for (int c = 0; c < 32; ++c) {
            const int t0 = c * 64, nb = c & 1;
            int lane = lane0; asm volatile("" : "+v"(lane));
            const int l31 = lane & 31, hi = lane >> 5, cp = (w & 1) * 64 + lane; LAS float* Vc = V + nb * 512;
            const int qkcol = (cp < 64) ? (h * 128 + 2 * cp) : (1024 + h * 128 + 2 * (cp - 64)); const unsigned vcol = (unsigned)(2048 + h * 256 + 2 * cp);
            {
                f32x2 x0 = (f32x2){bflo(xp[0]), bfhi(xp[0])}, x1 = (f32x2){bflo(xp[1]), bfhi(xp[1])}, x2 = (f32x2){bflo(xp[2]), bfhi(xp[2])};
                unsigned kga[8], kgb[8];
#pragma unroll
                for (int ii = 0; ii < 16; ++ii) {
                    const f32x2 x3 = (f32x2){bflo(xp[3 + ii]), bfhi(xp[3 + ii])}; f32x2 v = cw0 * x0 + cw1 * x1 + cw2 * x2 + cw3 * x3 + cbv;
                    v.x = v.x / (1.0f + __expf(-v.x)); v.y = v.y / (1.0f + __expf(-v.y));
                    x0 = x1; x1 = x2; x2 = x3; const int i = 16 * quarter + ii;
                    if (cp < 64) { *(LAS unsigned*)(L + QS + (i * QLD + 2 * cp) * 2) = pk2(v.x, v.y); }
                    else { const f32x2 kv = v * 0.08838834764831845f; *(LAS unsigned*)(L + KS + (i * QLD + 2 * (cp - 64)) * 2) = pk2(kv.x, kv.y);
                        const float gi = Vc[384 + i]; const unsigned ga = f2bf(kv.x * gi), gb = f2bf(kv.y * gi);
                        if (ii & 1) { kga[ii >> 1] |= ga << 16; kgb[ii >> 1] |= gb << 16; } else { kga[ii >> 1] = ga; kgb[ii >> 1] = gb; } }
                }
                if (cp >= 64) { const int d = 2 * (cp - 64);
#pragma unroll
                    for (int q4 = 0; q4 < 2; ++q4) { *(LAS v4u*)(L + KGT + (d * TLD + 16 * quarter + 8 * q4) * 2) = (v4u){kga[4 * q4], kga[4 * q4 + 1], kga[4 * q4 + 2], kga[4 * q4 + 3]};
                        *(LAS v4u*)(L + KGT + ((d + 1) * TLD + 16 * quarter + 8 * q4) * 2) = (v4u){kgb[4 * q4], kgb[4 * q4 + 1], kgb[4 * q4 + 2], kgb[4 * q4 + 3]}; } }
                unsigned va[8], vb[8];
#pragma unroll
                for (int ii = 0; ii < 16; ii += 2) { va[ii >> 1] = (vq[ii] & 0xffffu) | (vq[ii + 1] << 16); vb[ii >> 1] = (vq[ii] >> 16) | (vq[ii + 1] & 0xffff0000u); }
#pragma unroll
                for (int q4 = 0; q4 < 2; ++q4) { *(LAS v4u*)(L + VST + ((2 * cp) * TLD + 16 * quarter + 8 * q4) * 2) = (v4u){va[4 * q4], va[4 * q4 + 1], va[4 * q4 + 2], va[4 * q4 + 3]};
                    *(LAS v4u*)(L + VST + ((2 * cp + 1) * TLD + 16 * quarter + 8 * q4) * 2) = (v4u){vb[4 * q4], vb[4 * q4 + 1], vb[4 * q4 + 2], vb[4 * q4 + 3]}; }
                ML_ISSUE(c + 1, (unsigned)qkcol, vcol);
            }
            LBAR();
            v2u og[8]; f32x4 gn;
            if (w < 4) {
                const int jt = w & 1, it = w >> 1; f32x16 st = f32x16{};
#pragma unroll
                for (int s = 0; s < 8; ++s) {
                    const bf16x8 ka = *(const LAS bf16x8*)(L + KS + ((32 * jt + l31) * QLD + 16 * s + 8 * hi) * 2);
                    const bf16x8 qb = *(const LAS bf16x8*)(L + QS + ((32 * it + l31) * QLD + 16 * s + 8 * hi) * 2);
                    st = __builtin_amdgcn_mfma_f32_32x32x16_bf16(ka, qb, st, 0, 0, 0);
                }
                const int i = 32 * it + l31; const float Mi = Vc[192 + i]; float dsum = 0.f;
#pragma unroll
                for (int g4 = 0; g4 < 4; ++g4) {
                    float pv[4];
#pragma unroll
                    for (int e = 0; e < 4; ++e) { const int j = 32 * jt + 8 * g4 + 4 * hi + e; const float val = (j <= i) ? st[4 * g4 + e] * __expf(Vc[64 + j] - Mi) : 0.f; pv[e] = val; dsum += val; }
                    *(LAS v2u*)(L + PS + (i * TLD + 32 * jt + 8 * g4 + 4 * hi) * 2) = (v2u){cvtpk(pv[0], pv[1]), cvtpk(pv[2], pv[3])};
                }
                V[1024 + (jt * 2 + hi) * 64 + i] = dsum;
            } else {
                const LAS float* nv = V + 1344 + nb * 128; const float n0 = nv[lane], n1 = nv[lane + 64];
#pragma unroll 4
                for (int rr = 0; rr < 16; ++rr) { const int i = (w - 4) * 16 + rr;
                    const float q0 = bf2f(*(const LAS unsigned short*)(L + QS + (i * QLD + lane) * 2)), q1 = bf2f(*(const LAS unsigned short*)(L + QS + (i * QLD + lane + 64) * 2));
                    const float sdot = wave_sum(q0 * n0 + q1 * n1); if (lane == 0) V[1280 + i] = sdot; }
                if (w < 6) { const int k = (w - 4) * 64 + lane; float acc = 0.f;
#pragma unroll
                    for (int q8 = 0; q8 < 8; ++q8) { const v4u u = *(const LAS v4u*)(L + KGT + (k * TLD + 8 * q8) * 2); acc += bflo(u.x) + bfhi(u.x) + bflo(u.y) + bfhi(u.y) + bflo(u.z) + bfhi(u.z) + bflo(u.w) + bfhi(u.w); }
                    V[1344 + (nb ^ 1) * 128 + k] = Vc[448] * nv[k] + acc; }
                if (w == 7 && c < 31) ML_GATE_PREP(c + 1, lane);
            }
            LBAR();
            {
                bf16x8 bv[4];
#pragma unroll
                for (int js = 0; js < 4; ++js) bv[js] = *(const LAS bf16x8*)(L + VST + ((32 * w + l31) * TLD + 16 * js + 8 * hi) * 2);
                f32x16 ho[2];
#pragma unroll
                for (int it = 0; it < 2; ++it) {
                    f32x16 acc = f32x16{};
#pragma unroll
                    for (int kt = 0; kt < 4; ++kt)
#pragma unroll
                        for (int s = 0; s < 2; ++s) {
                            const bf16x4 qa = *(const LAS bf16x4*)(L + QS + ((32 * it + l31) * QLD + 32 * kt + 16 * s + 4 * hi) * 2);
                            const bf16x4 qb = *(const LAS bf16x4*)(L + QS + ((32 * it + l31) * QLD + 32 * kt + 16 * s + 8 + 4 * hi) * 2);
                            const bf16x8 aq = (bf16x8){qa[0], qa[1], qa[2], qa[3], qb[0], qb[1], qb[2], qb[3]};
                            const unsigned c0 = cvtpk(Ct[kt][8 * s + 0], Ct[kt][8 * s + 1]), c1 = cvtpk(Ct[kt][8 * s + 2], Ct[kt][8 * s + 3]), c2 = cvtpk(Ct[kt][8 * s + 4], Ct[kt][8 * s + 5]), c3 = cvtpk(Ct[kt][8 * s + 6], Ct[kt][8 * s + 7]);
                            const v4u cw = (v4u){c0, c1, c2, c3};
                            acc = __builtin_amdgcn_mfma_f32_32x32x16_bf16(aq, __builtin_bit_cast(bf16x8, cw), acc, 0, 0, 0);
                        }
#pragma unroll
                    for (int r = 0; r < 16; ++r) acc[r] *= Vc[256 + 32 * it + crow(r, hi)];
#pragma unroll
                    for (int js = 0; js < 4; ++js) { const bf16x8 pa = *(const LAS bf16x8*)(L + PS + ((32 * it + l31) * TLD + 16 * js + 8 * hi) * 2); acc = __builtin_amdgcn_mfma_f32_32x32x16_bf16(pa, bv[js], acc, 0, 0, 0); }
#pragma unroll
                    for (int r = 0; r < 16; ++r) { const int i = 32 * it + crow(r, hi); const float den = Vc[256 + i] * V[1280 + i] + (V[1024 + i] + V[1088 + i]) + (V[1152 + i] + V[1216 + i]);
                        acc[r] = acc[r] / fmaxf(fabsf(den), Vc[320 + i]); }
                    ho[it] = acc;
                }
#pragma unroll
                for (int rr = 0; rr < 8; ++rr) og[rr] = *(const v2u*)(qkvo + (size_t)(b * S + t0 + 8 * w + rr) * 6144 + 4096 + h * 256 + 4 * lane);
                gn = *(const f32x4*)(mhg + h * 256 + 4 * lane);
                const float adec = Vc[448];
#pragma unroll
                for (int kt = 0; kt < 4; ++kt) {
                    f32x16 cacc = Ct[kt] * adec;
#pragma unroll
                    for (int js = 0; js < 4; ++js) { const bf16x8 ka = *(const LAS bf16x8*)(L + KGT + ((32 * kt + l31) * TLD + 16 * js + 8 * hi) * 2); cacc = __builtin_amdgcn_mfma_f32_32x32x16_bf16(ka, bv[js], cacc, 0, 0, 0); }
                    Ct[kt] = cacc;
                }
                LBAR();
#pragma unroll
                for (int it = 0; it < 2; ++it)
#pragma unroll
                    for (int r = 0; r < 16; ++r) *(LAS unsigned short*)(L + QS + ((32 * it + crow(r, hi)) * HLD + 32 * w + l31) * 2) = (unsigned short)f2bf(ho[it][r]);
            }
            LBAR();
#pragma unroll
            for (int rr = 0; rr < 8; ++rr) {
                const int i = 8 * w + rr; const size_t grow = (size_t)(b * S + t0 + i);
                const v2u hw = *(const LAS v2u*)(L + QS + (i * HLD + 4 * lane) * 2);
                const float h0 = bflo(hw.x), h1 = bfhi(hw.x), h2 = bflo(hw.y), h3 = bfhi(hw.y);
                const float rstd = rsqrtf(wave_sum((h0 * h0 + h1 * h1) + (h2 * h2 + h3 * h3)) * (1.0f / 256.0f) + RMS_EPS);
                const v2u ow = og[rr];
                const float o0 = h0 * rstd * gn.x / (1.0f + __expf(-bflo(ow.x))), o1 = h1 * rstd * gn.y / (1.0f + __expf(-bfhi(ow.x))), o2 = h2 * rstd * gn.z / (1.0f + __expf(-bflo(ow.y))), o3 = h3 * rstd * gn.w / (1.0f + __expf(-bfhi(ow.y)));
                *(v2u*)(O + grow * 2048 + h * 256 + 4 * lane) = (v2u){pk2(o0, o1), pk2(o2, o3)};
            }
            LBAR();
        }
    }
#undef ML_ISSUE
#undef ML_GATE_PREP
}

__device__ __forceinline__ int lane_id() { int l; asm volatile("v_mbcnt_lo_u32_b32 %0, -1, 0\n\tv_mbcnt_hi_u32_b32 %0, -1, %0" : "=v"(l)); return l; }
__device__ __forceinline__ Frame mkframe(unsigned char* lds_generic, int wave_s, int dom) {
    Frame F; F.lds = (LAS unsigned char*)lds_generic; int w = wave_s; asm volatile("" : "+s"(w)); int t = w * 64 + lane_id(); asm volatile("" : "+v"(t));
    F.tid = t; F.lane = t & 63; F.wave = w; int g_ = gridDim.x, w_ = blockIdx.x; asm volatile("" : "+s"(g_), "+s"(w_)); F.gG = g_; F.gwg = w_;
    if (dom) { volatile LAS unsigned* st = (volatile LAS unsigned*)(F.lds + MISC_OFF) + 8; int r_ = __builtin_amdgcn_readfirstlane(st[2]), x_ = __builtin_amdgcn_readfirstlane(st[3]);
        F.G = 32; F.wg = r_; F.b0 = x_; F.b1 = x_ + 1; F.local = 1; }
    else { F.G = g_; F.wg = w_; F.b0 = 0; F.b1 = NB; F.local = 0; }
    return F;
}
__device__ __forceinline__ const float* inptr(LAS const unsigned* tbl, int i) {
    const unsigned lo = __builtin_amdgcn_readfirstlane(tbl[2 * i]), hi = __builtin_amdgcn_readfirstlane(tbl[2 * i + 1]);
    return (const float*)(const GAS float*)(((unsigned long long)hi << 32) | lo);
}
#define INP(i) inptr((LAS const unsigned*)((LAS unsigned char*)lds + LDSCTL_OFF + 4096), (i))
#define WSL(name) size_t name##_z = 0; asm volatile("" : "+s"(name##_z)); unsigned char* name = args.ws + name##_z; int gdim = gridDim.x, wgi = blockIdx.x; asm volatile("" : "+s"(gdim), "+s"(wgi))
__device__ __forceinline__ void conv_jobs(const Frame& F, LAS const unsigned* itab, unsigned char* ws, unsigned long long mask, int wg0, int nwg) {
#define INPF(i) inptr(itab, (i))
    Frame Fc = F; Fc.wg = F.wg - wg0; Fc.G = nwg;
        LAS unsigned* jt = (LAS unsigned*)(F.lds + LDSCTL_OFF + 1024);
        if (F.tid < 36) {
            const int job = F.tid; const float* W; int ldw, K, N, map = 3, col0 = 0, cmax = 0x7fffffff; bf16* WT;
            if (job < 8) { const int l = job >> 1; W = ((job & 1) ? INPF(7) : INPF(5)) + (size_t)l * D * 2 * FF; ldw = 2 * FF; K = D; N = 2 * FF; WT = (bf16*)(ws + WS_W_FFIN + (size_t)job * W_FFIN); map = 1; }
            else if (job < 16) { const int q = job - 8, l = q >> 1; W = ((q & 1) ? INPF(8) : INPF(6)) + (size_t)l * FF * D; ldw = D; K = FF; N = D; WT = (bf16*)(ws + WS_W_FFOUT + (size_t)q * W_FFOUT); }
            else if (job < 18) { const int j = job - 16; W = INPF(9) + (size_t)j * D * NSA_SRC; ldw = NSA_SRC; K = D; N = NSA_N; WT = (bf16*)(ws + WS_W_NSAIN + (size_t)j * W_NSAIN); map = 2; }
            else if (job < 22) { const int q = job - 18; W = INPF(11) + (size_t)q * 4096 * 512; ldw = 512; K = 4096; N = 512; WT = (bf16*)(ws + WS_W_CW1 + (size_t)q * W_CW1); }
            else if (job < 24) { const int j = job - 22; W = INPF(13) + (size_t)j * D * D; ldw = D; K = D; N = D; WT = (bf16*)(ws + WS_W_NSAOUT + (size_t)j * W_SQ); }
            else if (job < 26) { const int j = job - 24; W = INPF(14) + (size_t)j * D * ML_SRC; ldw = ML_SRC; K = D; N = ML_N; WT = (bf16*)(ws + WS_W_MLIN + (size_t)j * W_MLIN); }
            else if (job < 28) { const int j = job - 26; W = INPF(19) + (size_t)j * D * D; ldw = D; K = D; N = D; WT = (bf16*)(ws + WS_W_MLOUT + (size_t)j * W_SQ); }
            else if (job < 30) { const int j = job - 28; W = INPF(9) + (size_t)j * D * NSA_SRC; ldw = NSA_SRC; K = D; N = 64; WT = (bf16*)(ws + WS_WG + (size_t)j * 64 * D * 2); map = 0; col0 = NSA_N; cmax = NSA_SRC - 1; }
            else if (job < 32) { const int j = job - 30; W = INPF(14) + (size_t)j * D * ML_SRC; ldw = ML_SRC; K = D; N = 32; WT = (bf16*)(ws + WS_WG + (size_t)(2 * 64 + j * 32) * D * 2); map = 0; col0 = ML_N; cmax = ML_SRC - 1; }
            else { const int q = job - 32; W = INPF(12) + (size_t)q * 512 * 128; ldw = 128; K = 512; N = 128; WT = (bf16*)(ws + WS_WC2 + (size_t)q * 128 * 512 * 2); }
            const unsigned long long wq = (unsigned long long)W, tq = (unsigned long long)WT;
            jt[job * 12 + 0] = (unsigned)wq; jt[job * 12 + 1] = (unsigned)(wq >> 32); jt[job * 12 + 2] = (unsigned)tq; jt[job * 12 + 3] = (unsigned)(tq >> 32);
            jt[job * 12 + 4] = (unsigned)ldw; jt[job * 12 + 5] = (unsigned)K; jt[job * 12 + 6] = (unsigned)N; jt[job * 12 + 7] = (unsigned)map; jt[job * 12 + 8] = (unsigned)col0; jt[job * 12 + 9] = (unsigned)cmax;
        }
        __syncthreads();
#pragma nounroll
        for (int job = 0; job < 36; ++job) {
            if (!((mask >> job) & 1ull)) continue;
            unsigned d[10];
#pragma unroll
            for (int e = 0; e < 10; ++e) d[e] = __builtin_amdgcn_readfirstlane(jt[job * 12 + e]);
            const float* W = (const float*)(const GAS float*)(((unsigned long long)d[1] << 32) | d[0]); bf16* WT = (bf16*)(GAS bf16*)(((unsigned long long)d[3] << 32) | d[2]);
            const int ldw = (int)d[4], K = (int)d[5], N = (int)d[6], map = (int)d[7], col0 = (int)d[8], cmax = (int)d[9];
            if (map == 1) conv_matrix_v<1>(Fc, W, ldw, K, N, WT); else if (map == 2) conv_matrix_v<2>(Fc, W, ldw, K, N, WT); else if (map == 3) conv_matrix_v<3>(Fc, W, ldw, K, N, WT); else conv_matrix<0>(Fc, W, ldw, K, N, WT, col0, cmax);
        }
#undef INPF
}

constexpr unsigned long long jb(int i) { return 1ull << i; }
constexpr unsigned long long JOBS_G0 = jb(0) | jb(1) | jb(8) | jb(9) | jb(16) | jb(18) | jb(19) | jb(22) | jb(28) | jb(32) | jb(33) | jb(10) | jb(3) | jb(11);
constexpr unsigned long long JOBS_G1 = jb(24) | jb(26) | jb(30) | jb(2);
constexpr unsigned long long JOBS_G2 = jb(4) | jb(5) | jb(6) | jb(7) | jb(12) | jb(13) | jb(14) | jb(15) | jb(17) | jb(20) | jb(21) | jb(23) | jb(29) | jb(34) | jb(35) | jb(25) | jb(27) | jb(31);
static_assert((JOBS_G0 | JOBS_G1 | JOBS_G2) == (1ull << 36) - 1 && (JOBS_G0 & JOBS_G1) == 0 && (JOBS_G0 & JOBS_G2) == 0 && (JOBS_G1 & JOBS_G2) == 0, "every weight-copy job runs exactly once");
__global__ void __launch_bounds__(NWAVES * 64, 2) fwd_kernel(Args args, double rope_r) {
    extern __shared__ __attribute__((aligned(16))) unsigned char lds[];
    const int wave_s = __builtin_amdgcn_readfirstlane(threadIdx.x >> 6);
    { const int u = wave_s * 64 + lane_id(); if (u < 256) ((LAS unsigned*)((LAS unsigned char*)lds + LDSCTL_OFF))[u] = 0u; }
    if (wave_s == 0 && lane_id() == 0) { LAS unsigned long long* tb = (LAS unsigned long long*)((LAS unsigned char*)lds + LDSCTL_OFF + 4096);
#pragma unroll
        for (int i = 0; i < 20; ++i) tb[i] = (unsigned long long)args.in[i]; }
    __syncthreads();
    const int lo = args.ph_lo, hi = args.ph_hi;
    XcdBarrier bar; bar.bar = (unsigned*)(args.ws + WS_CTL) + CW_BAR; bar.x = 0; bar.st = nullptr; bar.w = wave_s;
    if (hi - lo > 1) bar = xcd_barrier_post((unsigned*)(args.ws + WS_CTL) + CW_BAR, (volatile LAS unsigned*)((LAS unsigned char*)lds + MISC_OFF) + 8, wave_s);
    int ph = 0;
#define RUN (ph >= lo && ph < hi)
#define SEAM_G do { if (ph >= lo && ph + 1 < hi) xcd_barrier(bar); ++ph; } while (0)
#define SEAM do { if (ph >= lo && ph + 1 < hi) { if (DOM) xcd_barrier_local(bar); else xcd_barrier(bar); } ++ph; } while (0)
#define DOM ((args.ph_hi - args.ph_lo == NPHASES_DEV) ? (int)__builtin_amdgcn_readfirstlane(((volatile LAS unsigned*)((LAS unsigned char*)lds + MISC_OFF))[12]) : 0)

    if (RUN) {
        const Frame F = mkframe(lds, wave_s, 0); WSL(ws);
        conv_jobs(F, (LAS const unsigned*)((LAS unsigned char*)lds + LDSCTL_OFF + 4096), ws, JOBS_G0, 0, F.G);
        __syncthreads();
        rope_table(F, (float*)(ws + WS_ROPE), (float*)(ws + WS_ROPE) + S * 64, rope_r);
        cbias_phase(F, INP(10), INP(11), (float*)(ws + WS_CBIAS));
        __syncthreads();
        mod_phase(F, INP(1), INP(2), INP(3), (float*)(ws + WS_MOD), 0, 2, 0, F.G);
        __syncthreads();
    }
    SEAM_G;

    int pend = 0, pl = 0, ps = 0;
#pragma nounroll
    for (int l = 0; l < DEPTH; ++l) {
        const int j = l >> 1;
#pragma nounroll
        for (int s = 0; s < 3; ++s) {
            if (RUN) {
                const Frame F = mkframe(lds, wave_s, DOM); WSL(ws);
                const float* MOD = (const float*)(ws + WS_MOD);
                ThinArgs ta; ta.xin = pend ? args.out : INP(0); ta.xout = args.out; ta.Y = (const bf16*)(ws + WS_Y); ta.coef = (ps == 1) ? 1.0f : 0.5f;
                ta.gate = MOD + (size_t)pl * NB * NMODC + (size_t)(3 * ps + 2) * D; ta.gpost = INP(4) + (size_t)pl * 6 * D + (size_t)(2 * ps + 1) * D;
                ta.gpre = INP(4) + (size_t)l * 6 * D + (size_t)(2 * s) * D;
                ta.shift = MOD + (size_t)l * NB * NMODC + (size_t)(3 * s) * D; ta.scale = ta.shift + D; ta.H = (bf16*)(ws + WS_H); ta.pend = pend; ta.pre = 1;
                thin_phase(F, ta);
            }
            SEAM;
            if (s != 1) {
                if (RUN) {
                    WSL(ws); const int wi = 2 * l + (s >> 1);
                    pg8::Gemm g{(const bf16*)(ws + WS_H), (const bf16*)(ws + WS_W_FFIN + (size_t)wi * W_FFIN), M, 2 * FF, D, D}; DomOrder So; { const Frame Fg = mkframe(lds, wave_s, DOM); So.init(M, 2 * FF, Fg); }
                    pg8::EpiSwiglu E{(bf16*)(ws + WS_HID), FF};
                    pg8::gemm_phase<pg8::EpiSwiglu, DomOrder, true, true>((LAS unsigned char*)lds, g, So, E, wave_s);
                }
                SEAM;
            } else if ((l & 1) == 0) {
                if (RUN) {
                    WSL(ws);
                    pg8::Gemm g{(const bf16*)(ws + WS_H), (const bf16*)(ws + WS_W_NSAIN + (size_t)j * W_NSAIN), M, NSA_N, D, D}; DomOrder So; { const Frame Fg = mkframe(lds, wave_s, DOM); So.init(M, NSA_N, Fg); }
                    pg8::EpiNsaQkv E{(bf16*)(ws + WS_QRAW), (bf16*)(ws + WS_QROT), (bf16*)(ws + WS_KV), KV_STRIDE, (const float*)(ws + WS_ROPE), (const float*)(ws + WS_ROPE) + S * 64};
                    pg8::gemm_phase<pg8::EpiNsaQkv, DomOrder, true, true>((LAS unsigned char*)lds, g, So, E, wave_s);
                }
                SEAM;
                if (RUN) {
                    WSL(ws);
                    const Frame F = mkframe(lds, wave_s, DOM);
                    const int it = F.wg, nun = 8 * (F.b1 - F.b0), t = (it >> 2) & 1;
                    pg8::Gemm g{(const bf16*)(ws + WS_KV) + (size_t)t * KV_STRIDE, (const bf16*)(ws + WS_W_CW1 + (size_t)(j * 2 + t) * W_CW1), 4096, 512, 4096, 2048};
                    OneUnit So{2 * (F.b0 + (it >> 3)) + ((it >> 1) & 1), it & 1, it < nun ? 1 : 0};
                    pg8::EpiBiasSilu E{(bf16*)(ws + WS_CHID) + (size_t)t * 4096 * 512, 512, (const float*)(ws + WS_CBIAS) + (size_t)(j * 2 + t) * 512};
                    pg8::gemm_phase<pg8::EpiBiasSilu, OneUnit, true, true>((LAS unsigned char*)lds, g, So, E, wave_s);
                    __syncthreads();
                    { const int idle0 = F.local ? 8 : 64, nidle = F.local ? 8 * 24 : F.gG - 64, idx = F.local ? F.b0 * 24 + (F.wg - 8) : F.gwg - 64;
                      if (l == 0 && F.wg >= idle0) { Frame Fi = F; Fi.wg = idx + 64; conv_jobs(Fi, (LAS const unsigned*)((LAS unsigned char*)lds + LDSCTL_OFF + 4096), ws, JOBS_G1, 64, nidle); __syncthreads(); } }
                    thin_proj<0, 3>(F, (const bf16*)(ws + WS_H), (const bf16*)(ws + WS_WG + (size_t)j * 64 * D * 2), nullptr, (float*)(ws + WS_GATE), 48);
                }
                SEAM;
                if (RUN) { const Frame F = mkframe(lds, wave_s, DOM); WSL(ws); cmp2_mfma(F, (const bf16*)(ws + WS_CHID), (const bf16*)(ws + WS_WC2 + (size_t)j * 2 * 128 * 512 * 2), (bf16*)(ws + WS_KCVC)); }
                SEAM;
                if (RUN) { const Frame F = mkframe(lds, wave_s, DOM); WSL(ws); imp_phase_mfma(F, (char*)lds, (const bf16*)(ws + WS_QRAW), (const bf16*)(ws + WS_KCVC), (const bf16*)(ws + WS_KCVC) + 4096 * 128, (const float*)(ws + WS_GATE), (float*)(ws + WS_OACC), (unsigned*)(ws + WS_MASK)); }
                SEAM;
                if (RUN) { const Frame F = mkframe(lds, wave_s, DOM); WSL(ws);
                    att_phase_mfma(F, (char*)lds, (const bf16*)(ws + WS_QROT), (const bf16*)(ws + WS_KV), (const float*)(ws + WS_GATE), (float*)(ws + WS_OACC), (const unsigned*)(ws + WS_MASK), (bf16*)(ws + WS_O)); }
                SEAM;
            } else {
                if (RUN) {
                    WSL(ws);
                    pg8::Gemm g{(const bf16*)(ws + WS_H), (const bf16*)(ws + WS_W_MLIN + (size_t)j * W_MLIN), M, ML_N, D, D}; DomOrder So; { const Frame Fg = mkframe(lds, wave_s, DOM); So.init(M, ML_N, Fg); }
                    pg8::EpiBf16 E{(bf16*)(ws + WS_MLQ), ML_N};
                    pg8::gemm_phase<pg8::EpiBf16, DomOrder, true, true>((LAS unsigned char*)lds, g, So, E, wave_s);
                    __syncthreads();
                    { const Frame F = mkframe(lds, wave_s, DOM); thin_proj<1, 1>(F, (const bf16*)(ws + WS_H), (const bf16*)(ws + WS_WG + (size_t)(2 * 64 + j * 32) * D * 2), INP(17) + (size_t)j * 16, (float*)(ws + WS_GATE), 16); }
                }
                SEAM;
                if (RUN) { const Frame F = mkframe(lds, wave_s, DOM); WSL(ws); mlstm_cell_mfma(F, (const bf16*)(ws + WS_MLQ), (const float*)(ws + WS_GATE), INP(15) + (size_t)j * 4 * 2048, INP(16) + (size_t)j * 2048, INP(18) + (size_t)j * 2048, (bf16*)(ws + WS_O));  if (l == 1) { const Frame F2 = mkframe(lds, wave_s, DOM); const int idle0 = F2.local ? 8 : 64, nidle = F2.local ? 8 * 24 : F2.gG - 64, idx = F2.local ? F2.b0 * 24 + (F2.wg - 8) : F2.gwg - 64; if (F2.wg >= idle0) { Frame Fi = F2; Fi.wg = idx + 64; __syncthreads(); conv_jobs(Fi, (LAS const unsigned*)((LAS unsigned char*)lds + LDSCTL_OFF + 4096), ws, JOBS_G2, 64, nidle); __syncthreads(); mod_phase(Fi, INP(1), INP(2), INP(3), (float*)(ws + WS_MOD), 2, 2, 64, nidle); } } }
                SEAM;
            }
            if (RUN) {
                WSL(ws);
                const bf16* Ay; const bf16* By; int Ky;
                if (s != 1) { Ay = (const bf16*)(ws + WS_HID); By = (const bf16*)(ws + WS_W_FFOUT + (size_t)(2 * l + (s >> 1)) * W_FFOUT); Ky = FF; }
                else { Ay = (const bf16*)(ws + WS_O); By = (const bf16*)(ws + ((l & 1) ? WS_W_MLOUT : WS_W_NSAOUT) + (size_t)j * W_SQ); Ky = D; }
                pg8::Gemm g{Ay, By, M, D, Ky, Ky}; DomOrder So; { const Frame Fg = mkframe(lds, wave_s, DOM); So.init(M, D, Fg); }
                pg8::EpiBf16 E{(bf16*)(ws + WS_Y), D};
                pg8::gemm_phase<pg8::EpiBf16, DomOrder, true, true>((LAS unsigned char*)lds, g, So, E, wave_s);
            }
            if (s == 2 && l <= 1) SEAM_G; else SEAM;
            pend = 1; pl = l; ps = s;
        }
    }
    if (RUN) {
        const Frame F = mkframe(lds, wave_s, DOM); WSL(ws);
        const float* MOD = (const float*)(ws + WS_MOD);
        ThinArgs ta; ta.xin = args.out; ta.xout = args.out; ta.Y = (const bf16*)(ws + WS_Y); ta.coef = 0.5f;
        ta.gate = MOD + (size_t)pl * NB * NMODC + (size_t)(3 * ps + 2) * D; ta.gpost = INP(4) + (size_t)pl * 6 * D + (size_t)(2 * ps + 1) * D;
        ta.gpre = nullptr; ta.shift = nullptr; ta.scale = nullptr; ta.H = nullptr; ta.pend = 1; ta.pre = 0;
        thin_phase(F, ta);
    }
    SEAM;
#undef RUN
#undef SEAM
#undef SEAM_G
#undef DOM
}

constexpr int NPHASES = 1 + 2 * 13 + 2 * 10 + 1;
#ifndef N_LAUNCH_MODE
#define N_LAUNCH_MODE 1
#endif
extern "C" void kernel_launch(void* const* d_in, const int* in_sizes, int n_in, void* d_out, int out_size, void* d_ws, size_t ws_size, hipStream_t stream) {
    static int grid = 0;
    if (grid == 0) {
        if (n_in != 20 || in_sizes[0] != M * D || out_size != M * D || ws_size < WS_END) { fprintf(stderr, "kernel_launch: unexpected shapes: n_in %d in0 %d out %d ws %zu (need %zu)\n", n_in, n_in > 0 ? in_sizes[0] : -1, out_size, ws_size, (size_t)WS_END); grid = -1; return; }
        int dev = 0, cus = 0, per_cu = 0;
        if (hipGetDevice(&dev) != hipSuccess || hipDeviceGetAttribute(&cus, hipDeviceAttributeMultiprocessorCount, dev) != hipSuccess) { grid = -1; return; }
        if (hipFuncSetAttribute((const void*)fwd_kernel, hipFuncAttributeMaxDynamicSharedMemorySize, LDS_BYTES) != hipSuccess) { fprintf(stderr, "kernel_launch: hipFuncSetAttribute failed\n"); grid = -1; return; }
        if (hipOccupancyMaxActiveBlocksPerMultiprocessor(&per_cu, (const void*)fwd_kernel, NWAVES * 64, LDS_BYTES) != hipSuccess || per_cu < 1) fprintf(stderr, "kernel_launch: occupancy query says %d\n", per_cu);
        (void)hipGetLastError();
        grid = cus;
    }
    if (grid < 0) return;
    if (hipMemsetAsync((char*)d_ws + WS_CTL, 0, CTL_ZERO_BYTES, stream) != hipSuccess) return;
    Args a{};
    for (int i = 0; i < 20; ++i) a.in[i] = (const float*)d_in[i];
    a.out = (float*)d_out; a.ws = (unsigned char*)d_ws;
    const double rope_r = 0.86596432336006535;
    if (N_LAUNCH_MODE == 1) {
        a.ph_lo = 0; a.ph_hi = NPHASES;
        hipLaunchKernelGGL(fwd_kernel, dim3(grid), dim3(NWAVES * 64), LDS_BYTES, stream, a, rope_r);
    } else {
        for (int p = 0; p < NPHASES; ++p) { a.ph_lo = p; a.ph_hi = p + 1; hipLaunchKernelGGL(fwd_kernel, dim3(grid), dim3(NWAVES * 64), LDS_BYTES, stream, a, rope_r); }
    }
    const hipError_t le = hipPeekAtLastError();
    if (le != hipSuccess) fprintf(stderr, "kernel_launch: launch failed: %s\n", hipGetErrorName(le));
}
```
